# Optimizing an MI355X kernel written in HIP

```python
import math
import jax, jax.numpy as jnp
from jax import lax
import numpy as np

D_MODEL = 2048
BATCH = 2
SEQ = 8192
DEPTH = 4

CHUNK = 64
N_MEM = 256
N_MIXERS = 2
N_A = (DEPTH + 1) // 2
N_B = DEPTH // 2
HEAD_DIM = 128
MEM_W = D_MODEL // 4
MEM_HEADS = MEM_W // HEAD_DIM
TOK_W = D_MODEL - MEM_W
SB_HEADS = TOK_W // HEAD_DIM
SB_BLOCK = 128
S5_GROUP = 16
S5_GROUPS = TOK_W // S5_GROUP
S5_STATE = 64
FFN_DIM = 256 * math.ceil(8 * D_MODEL / 3 / 256)
EPS = 1e-6

kernel_name = "hybrid_stickbreak_s5_macaron_memory_trunk"


def rms_norm(x, g):
    x32 = x.astype(jnp.float32)
    y = x32 * lax.rsqrt(jnp.mean(x32 * x32, axis=-1, keepdims=True) + EPS) * g.astype(jnp.float32)
    return y.astype(x.dtype)


def swiglu_ffn(h, w_gu, w_down):
    g, u = jnp.split(h @ w_gu, 2, axis=-1)
    return (jax.nn.silu(g) * u) @ w_down


def stick_breaking_attention(q, k, v):
    B, L, H, d = q.shape
    q, k, v = (a.transpose(0, 2, 1, 3) for a in (q, k, v))
    scale = 1.0 / math.sqrt(d)
    outs = []
    for qs in range(0, L, SB_BLOCK):
        qe = qs + SB_BLOCK
        z = jnp.einsum("bhqd,bhkd->bhqk", q[:, :, qs:qe], k[:, :, :qe]).astype(jnp.float32) * scale
        t_idx = qs + jnp.arange(SB_BLOCK)[:, None]
        s_idx = jnp.arange(qe)[None, :]
        before = s_idx < t_idx
        log_not = jnp.where(before, jax.nn.log_sigmoid(-z), 0.0)
        between = lax.cumsum(log_not, axis=3, reverse=True) - log_not
        w = jnp.where(before, jnp.exp(jax.nn.log_sigmoid(z) + between), 0.0)
        outs.append(jnp.einsum("bhqk,bhkd->bhqd", w.astype(v.dtype), v[:, :, :qe]))
    o = jnp.concatenate(outs, axis=2)
    return o.transpose(0, 2, 1, 3).reshape(B, L, H * d)


def _ssm_combine(left, right):
    a_l, b_l = left
    a_r, b_r = right
    return (a_r * a_l, a_r * b_l + b_r)


def s5_glu(u, log_dt, a_re, a_im, b_re, b_im, c_re, c_im, d_skip, w_glu):
    B, L, _ = u.shape
    f32 = jnp.float32
    dt = jnp.exp(log_dt.astype(f32))[:, None]
    lam = lax.complex(a_re.astype(f32), a_im.astype(f32))
    a_bar = jnp.exp(lam * dt)
    b = lax.complex(b_re.astype(f32), b_im.astype(f32))
    b_bar = ((a_bar - 1.0) / lam)[..., None] * b
    c = lax.complex(c_re.astype(f32), c_im.astype(f32))
    uc = u.astype(f32).reshape(B, L, S5_GROUPS, S5_GROUP)
    bu = jnp.einsum("gnc,blgc->blgn", b_bar, uc.astype(jnp.complex64))
    a_elems = jnp.broadcast_to(a_bar[None, None], bu.shape)
    _, states = lax.associative_scan(_ssm_combine, (a_elems, bu), axis=1)
    y = jnp.einsum("gcn,blgn->blgc", c, states).real + d_skip.astype(f32).reshape(S5_GROUPS, S5_GROUP) * uc
    y = jax.nn.gelu(y.reshape(B, L, TOK_W))
    y = y * jax.nn.sigmoid(y @ w_glu.astype(f32))
    return y.astype(u.dtype)


def memory_cross_attention(q, mem_h, w_mem_kv, q_gain, k_gain):
    B, L, _ = q.shape
    M = mem_h.shape[1]
    k, v = jnp.split(mem_h @ w_mem_kv, 2, axis=-1)
    q = rms_norm(q.reshape(B, L, MEM_HEADS, HEAD_DIM), q_gain)
    k = rms_norm(k.reshape(B, M, MEM_HEADS, HEAD_DIM), k_gain)
    v = v.reshape(B, M, MEM_HEADS, HEAD_DIM)
    s = jnp.einsum("blhd,bmhd->bhlm", q, k).astype(jnp.float32) / math.sqrt(HEAD_DIM)
    p = jax.nn.softmax(s, axis=-1).astype(v.dtype)
    o = jnp.einsum("bhlm,bmhd->blhd", p, v)
    return o.reshape(B, L, MEM_W)


def setup_inputs(seed: int = 0) -> dict:
    key = jax.random.key(seed)
    ks = jax.random.split(key, 32)
    f32 = jnp.float32

    def nrm(k, shape, fan_in):
        return jax.random.normal(k, shape, f32) * fan_in ** -0.5

    def gain(k, shape):
        return 1.0 + 0.02 * jax.random.normal(k, shape, f32)

    G, N, C = S5_GROUPS, S5_STATE, S5_GROUP
    return dict(
        x=jax.random.normal(ks[0], (BATCH, SEQ, D_MODEL), f32),
        mem=jax.random.normal(ks[1], (BATCH, N_MEM, D_MODEL), f32),
        ffn1_norm=gain(ks[2], (DEPTH, D_MODEL)),
        ffn1_w_gu=nrm(ks[3], (DEPTH, D_MODEL, 2 * FFN_DIM), D_MODEL),
        ffn1_w_down=nrm(ks[4], (DEPTH, FFN_DIM, D_MODEL), FFN_DIM),
        mix_norm=gain(ks[5], (DEPTH, D_MODEL)),
        mem_norm=gain(ks[6], (DEPTH, D_MODEL)),
        w_mem_kv=nrm(ks[7], (DEPTH, D_MODEL, 2 * MEM_W), D_MODEL),
        xq_norm=gain(ks[8], (DEPTH, HEAD_DIM)),
        xk_norm=gain(ks[9], (DEPTH, HEAD_DIM)),
        w_out=nrm(ks[10], (DEPTH, TOK_W + MEM_W, D_MODEL), TOK_W + MEM_W),
        ffn2_norm=gain(ks[11], (DEPTH, D_MODEL)),
        ffn2_w_gu=nrm(ks[12], (DEPTH, D_MODEL, 2 * FFN_DIM), D_MODEL),
        ffn2_w_down=nrm(ks[13], (DEPTH, FFN_DIM, D_MODEL), FFN_DIM),
        sb_w_in=nrm(ks[14], (N_A, D_MODEL, 3 * TOK_W + MEM_W), D_MODEL),
        s5_w_in=nrm(ks[15], (N_B, D_MODEL, TOK_W + MEM_W), D_MODEL),
        s5_log_dt=jax.random.uniform(ks[16], (N_B, G), f32, math.log(1e-3), math.log(1e-1)),
        s5_a_re=-0.5 + 0.01 * jax.random.normal(ks[17], (N_B, G, N), f32),
        s5_a_im=jnp.pi * jnp.arange(N, dtype=f32) + 0.01 * jax.random.normal(ks[18], (N_B, G, N), f32),
        s5_b_re=nrm(ks[19], (N_B, G, N, C), 2 * C),
        s5_b_im=nrm(ks[20], (N_B, G, N, C), 2 * C),
        s5_c_re=nrm(ks[21], (N_B, G, C, N), 2 * N),
        s5_c_im=nrm(ks[22], (N_B, G, C, N), 2 * N),
        s5_d=jax.random.normal(ks[23], (N_B, TOK_W), f32),
        s5_w_glu=nrm(ks[24], (N_B, TOK_W, TOK_W), TOK_W),
    )


def reference(x, mem, ffn1_norm, ffn1_w_gu, ffn1_w_down, mix_norm, mem_norm, w_mem_kv,
              xq_norm, xk_norm, w_out, ffn2_norm, ffn2_w_gu, ffn2_w_down, sb_w_in,
              s5_w_in, s5_log_dt, s5_a_re, s5_a_im, s5_b_re, s5_b_im, s5_c_re, s5_c_im,
              s5_d, s5_w_glu):
    B, L, _ = x.shape
    for i in range(DEPTH):
        x = x + 0.5 * swiglu_ffn(rms_norm(x, ffn1_norm[i]), ffn1_w_gu[i], ffn1_w_down[i])
        h = rms_norm(x, mix_norm[i])
        j = i // N_MIXERS
        if i % N_MIXERS == 0:
            q, k, v, q_mem = jnp.split(h @ sb_w_in[j], [TOK_W, 2 * TOK_W, 3 * TOK_W], axis=-1)
            shp = (B, L, SB_HEADS, HEAD_DIM)
            tok = stick_breaking_attention(q.reshape(shp), k.reshape(shp), v.reshape(shp))
        else:
            u, q_mem = jnp.split(h @ s5_w_in[j], [TOK_W], axis=-1)
            tok = s5_glu(u, s5_log_dt[j], s5_a_re[j], s5_a_im[j], s5_b_re[j], s5_b_im[j],
                         s5_c_re[j], s5_c_im[j], s5_d[j], s5_w_glu[j])
        mem_h = rms_norm(mem, mem_norm[i])
        cross = memory_cross_attention(q_mem, mem_h, w_mem_kv[i], xq_norm[i], xk_norm[i])
        x = x + jnp.concatenate([tok, cross], axis=-1) @ w_out[i]
        x = x + 0.5 * swiglu_ffn(rms_norm(x, ffn2_norm[i]), ffn2_w_gu[i], ffn2_w_down[i])
    return x
```

```cpp
#include <hip/hip_runtime.h>
#include <cstdio>
#include <cstdint>

#define LAS __attribute__((address_space(3)))
#define GAS __attribute__((address_space(1)))
typedef unsigned short bf16;
typedef short bf16x8 __attribute__((ext_vector_type(8)));
typedef short bf16x4 __attribute__((ext_vector_type(4)));
typedef float f32x4 __attribute__((ext_vector_type(4)));
typedef float f32x2 __attribute__((ext_vector_type(2)));
typedef unsigned u32x4 __attribute__((ext_vector_type(4)));
typedef unsigned u32x2 __attribute__((ext_vector_type(2)));
typedef unsigned long long u64;
__device__ __forceinline__ float rss2f(u64 v) { return __builtin_fmaf((float)(unsigned)(v >> 32), 4096.0f, (float)(unsigned)v * (1.0f / 1048576.0f)); }

constexpr int BATCH = 2, SEQ = 8192, DM = 2048, DEPTH = 4, M = BATCH * SEQ;
constexpr int NMEM = 256, HD = 128, MEMW = 512, MEMHEADS = 4, TOKW = 1536, SBH = 12;
constexpr int FFN = 5632, S5G = 96, S5C = 16, S5N = 64;
constexpr int PROJ_SB = 3584;
constexpr int PROJ_S5 = 2048;
constexpr int S5T = 256, S5NC = SEQ / S5T, S5T_LOG2 = 8;
constexpr float EPS = 1e-6f;

constexpr size_t MiB = 1u << 20;
constexpr size_t WS_CTL = 0, CTL_ZERO_BYTES = 3 * MiB;
constexpr size_t WS_RSS = 1 * MiB;
constexpr size_t SZ_GU = (size_t)2 * FFN * DM * 2, SZ_DN = (size_t)DM * FFN * 2, SZ_OUT = (size_t)DM * DM * 2, SZ_KV = (size_t)1024 * DM * 2;
constexpr size_t SZ_INSB = (size_t)5120 * DM * 2, SZ_INS5 = (size_t)DM * DM * 2, SZ_GLU = (size_t)TOKW * TOKW * 2;
constexpr size_t WS_WGU1 = 3 * MiB;
constexpr size_t WS_WDN1 = WS_WGU1 + 4 * SZ_GU;
constexpr size_t WS_WGU2 = WS_WDN1 + 4 * SZ_DN;
constexpr size_t WS_WDN2 = WS_WGU2 + 4 * SZ_GU;
constexpr size_t WS_WOUT = WS_WDN2 + 4 * SZ_DN;
constexpr size_t WS_WKV = WS_WOUT + 4 * SZ_OUT;
constexpr size_t WS_WINSB = WS_WKV + 4 * SZ_KV;
constexpr size_t WS_WINS5 = WS_WINSB + 2 * SZ_INSB;
constexpr size_t WS_WGLU = WS_WINS5 + 2 * SZ_INS5;
constexpr size_t WS_XN = WS_WGLU + 2 * SZ_GLU;
constexpr size_t WS_ACT = WS_XN + (size_t)M * DM * 2;
constexpr size_t WS_PROJ = WS_ACT + (size_t)M * FFN * 2;
constexpr size_t WS_VT = WS_PROJ + (size_t)M * PROJ_SB * 2;
constexpr size_t WS_TOK = WS_VT + (size_t)TOKW * M * 2;
constexpr size_t WS_MEMH = WS_TOK + (size_t)M * DM * 2;
constexpr size_t WS_KVM = WS_MEMH + (size_t)4 * 512 * DM * 2;
constexpr size_t WS_KN = WS_KVM + (size_t)4 * 512 * 1024 * 2;
constexpr size_t WS_VTM = WS_KN + (size_t)4 * 2 * 4 * 256 * 128 * 2;
constexpr size_t WS_BBAR = WS_VTM + (size_t)4 * 2 * 4 * 256 * 128 * 2;
constexpr size_t WS_CCAT = WS_BBAR + (size_t)2 * 96 * 128 * 16 * 2;
constexpr size_t WS_ABAR = WS_CCAT + (size_t)2 * 96 * 16 * 128 * 2;
constexpr size_t WS_E = WS_ABAR + (size_t)2 * 96 * 64 * 16;
constexpr size_t WS_RK = WS_E + (size_t)2 * 96 * S5NC * 64 * 8;
constexpr size_t WS_END = WS_RK + (size_t)M * 4;
constexpr int CW_BAR = 4096;

constexpr int RING_BYTES = 131072;
constexpr int LDS_BYTES = 163840;
constexpr int LDSCTL_OFF = LDS_BYTES - 512, MISC_OFF = LDSCTL_OFF + 320;
constexpr int XK_ROWB = 256 + 16, XV_ROWB = 512 + 16, XV_OFF = 256 * XK_ROWB, X_STAGE_BYTES = XV_OFF + 128 * XV_ROWB;
static_assert(X_STAGE_BYTES <= LDSCTL_OFF, "cross-attention K/V image fits under the LDS control words");

namespace pg8 {
constexpr int BM = 256, BK = 64, HALF = 128, HTB = HALF * BK * 2, STAGE_BYTES = 8 * HTB, NXCD = 8, WGM = 8;
__host__ __device__ __forceinline__ int lds_byte(int r, int c) { const int st = (r >> 4) * 2 + (c >> 5), rr = r & 15, cc = c & 31, ob = rr * 64 + cc * 2; return st * 1024 + (ob ^ (((ob >> 9) & 1) << 5)); }
__host__ __device__ __forceinline__ void stage_rc(int b, int& R, int& C) { const int st = b / 1024, sb = b % 1024, swz = sb ^ (((sb >> 9) & 1) << 5); R = (st >> 1) * 16 + swz / 64; C = (st & 1) * 32 + (swz % 64) / 2; }
__host__ __device__ __forceinline__ int perm32(int rho) { const int n = rho >> 4, i = rho & 15; return 8 * (i >> 2) + 4 * n + (i & 3); }

struct Unit { int pm, pn, sel; };
struct TileOrder {
    int nM, nN, nwg;
    __device__ __forceinline__ void init(int Mr, int Nc) { nM = Mr / BM; nN = Nc / BM; nwg = nM * nN; }
    __device__ __forceinline__ void map(int L, int& pm, int& pn) const {
        int wgid = L; { const int q = nwg / NXCD, r = nwg % NXCD, xcd = wgid % NXCD, off = wgid / NXCD; wgid = (xcd < r ? xcd * (q + 1) : r * (q + 1) + (xcd - r) * q) + off; }
        const int nig = WGM * nN, gid = wgid / nig, fm = gid * WGM, gsz = (nM - fm) < WGM ? (nM - fm) : WGM;
        pm = fm + ((wgid % nig) % gsz); pn = (wgid % nig) / gsz;
    }
};
struct DualSched {
    TileOrder t1, t2; const char *A1, *B1, *A2, *B2; size_t tstep; int G, c;
    __device__ __forceinline__ bool next(int i, Unit& u) const {
        const int L = i * G + c;
        if (L < t1.nwg) { t1.map(L, u.pm, u.pn); u.sel = 0; return true; }
        if (L < t1.nwg + t2.nwg) { t2.map(L - t1.nwg, u.pm, u.pn); u.sel = 1; return true; }
        return false;
    }
    __device__ __forceinline__ const char* a_ptr(const Unit& u) const { return (u.sel ? A2 : A1) + (size_t)u.pm * tstep; }
    __device__ __forceinline__ const char* b_ptr(const Unit& u) const { return (u.sel ? B2 : B1) + (size_t)u.pn * tstep; }
};
struct KvSched {
    const char *A, *B; size_t tstep; int G, c;
    __device__ __forceinline__ bool next(int i, Unit& u) const { const int L = i * G + c; if (L >= 32) return false; const int layer = L >> 3; u.pm = 2 * layer + (L & 1); u.pn = 4 * layer + ((L >> 1) & 3); u.sel = 0; return true; }
    __device__ __forceinline__ const char* a_ptr(const Unit& u) const { return A + (size_t)u.pm * tstep; }
    __device__ __forceinline__ const char* b_ptr(const Unit& u) const { return B + (size_t)u.pn * tstep; }
};

__device__ __forceinline__ unsigned cvt_pk_bf16(float lo, float hi) { unsigned r; asm volatile("v_cvt_pk_bf16_f32 %0, %1, %2" : "=v"(r) : "v"(lo), "v"(hi)); return r; }
__device__ __forceinline__ float fexp(float x) { return __builtin_amdgcn_exp2f(x * 1.4426950408889634f); }
__device__ __forceinline__ float flog(float x) { return __builtin_amdgcn_logf(x) * 0.6931471805599453f; }
__device__ __forceinline__ float fsigmoid(float x) { return __builtin_amdgcn_rcpf(1.0f + fexp(-x)); }

struct EpiSwiGLU {
    static constexpr bool PERM = true;
    struct Pre { u64 rs[8]; };
    bf16* O; int ldc; const u64* rss;
    __device__ __forceinline__ void prefetch(Pre& p, const Unit& u, int wr, int fr) const {
        const GAS u64* r = (const GAS u64*)rss + u.pm * BM + wr * 64 + fr;
#pragma unroll
        for (int ai = 0; ai < 2; ++ai)
#pragma unroll
            for (int m = 0; m < 4; ++m) p.rs[ai * 4 + m] = r[ai * HALF + m * 16];
    }
    __device__ __forceinline__ void operator()(const f32x4 (&acc)[2][2][4][2], const Unit& u, const Pre& p, int wr, int wc, int fr, int fq) const {
        const int row0 = u.pm * BM + wr * 64 + fr, col0 = u.pn * HALF + wc * 32 + 8 * fq;
#pragma unroll
        for (int ai = 0; ai < 2; ++ai)
#pragma unroll
            for (int m = 0; m < 4; ++m) {
                GAS bf16* rowp = (GAS bf16*)O + (size_t)(row0 + ai * HALF + m * 16) * ldc + col0;
                const float rr = __builtin_amdgcn_rsqf(rss2f(p.rs[ai * 4 + m]) * (1.0f / DM) + EPS);
                const float nl = -1.4426950408889634f * rr, rr2 = rr * rr;
                f32x2 t2[4], gu[4], o2[4];
#pragma unroll
                for (int q = 0; q < 4; ++q) { const f32x2 ag = (f32x2){acc[ai][0][m][q >> 1][2 * (q & 1)], acc[ai][0][m][q >> 1][2 * (q & 1) + 1]}, au = (f32x2){acc[ai][1][m][q >> 1][2 * (q & 1)], acc[ai][1][m][q >> 1][2 * (q & 1) + 1]};
                    t2[q] = ag * nl; gu[q] = (ag * au) * rr2; }
#pragma unroll
                for (int q = 0; q < 4; ++q) { t2[q].x = __builtin_amdgcn_exp2f(t2[q].x); t2[q].y = __builtin_amdgcn_exp2f(t2[q].y); }
#pragma unroll
                for (int q = 0; q < 4; ++q) { t2[q] = t2[q] + 1.0f; }
#pragma unroll
                for (int q = 0; q < 4; ++q) { t2[q].x = __builtin_amdgcn_rcpf(t2[q].x); t2[q].y = __builtin_amdgcn_rcpf(t2[q].y); }
#pragma unroll
                for (int q = 0; q < 4; ++q) o2[q] = gu[q] * t2[q];
                u32x4 w; w.x = cvt_pk_bf16(o2[0].x, o2[0].y); w.y = cvt_pk_bf16(o2[1].x, o2[1].y); w.z = cvt_pk_bf16(o2[2].x, o2[2].y); w.w = cvt_pk_bf16(o2[3].x, o2[3].y);
                *(GAS u32x4*)rowp = w;
            }
    }
};
struct EpiResid {
    static constexpr bool PERM = true;
    struct Pre {};
    bf16* xb; int ldc; float scale; u64* rss; float* outf;
    __device__ __forceinline__ void prefetch(Pre&, const Unit&, int, int) const {}
    __device__ __forceinline__ void operator()(const f32x4 (&acc)[2][2][4][2], const Unit& u, const Pre&, int wr, int wc, int fr, int fq) const {
        const int row0 = u.pm * BM + wr * 64 + fr, col0 = u.pn * BM + wc * 32 + 8 * fq;
#pragma unroll
        for (int ai = 0; ai < 2; ++ai) {
            u32x4 bs[4][2];
#pragma unroll
            for (int m = 0; m < 4; ++m)
#pragma unroll
                for (int bj = 0; bj < 2; ++bj) bs[m][bj] = *(const GAS u32x4*)((const GAS bf16*)xb + (size_t)(row0 + ai * HALF + m * 16) * ldc + col0 + bj * HALF);
#pragma unroll
            for (int m = 0; m < 4; ++m) { const size_t off = (size_t)(row0 + ai * HALF + m * 16) * ldc + col0; float s = 0.f;
#pragma unroll
                for (int bj = 0; bj < 2; ++bj) { float v[8];
#pragma unroll
                    for (int j = 0; j < 4; ++j) { const unsigned w = bs[m][bj][j]; const float lo = __uint_as_float(w << 16), hi = __uint_as_float(w & 0xffff0000u);
                        const float a0 = (j < 2) ? acc[ai][bj][m][0][2 * j] : acc[ai][bj][m][1][2 * j - 4], a1 = (j < 2) ? acc[ai][bj][m][0][2 * j + 1] : acc[ai][bj][m][1][2 * j - 3];
                        v[2 * j] = lo + a0 * scale; v[2 * j + 1] = hi + a1 * scale; }
                    if (outf) { *(GAS f32x4*)((GAS float*)outf + off + bj * HALF) = (f32x4){v[0], v[1], v[2], v[3]}; *(GAS f32x4*)((GAS float*)outf + off + bj * HALF + 4) = (f32x4){v[4], v[5], v[6], v[7]}; }
                    else { u32x4 w; w.x = cvt_pk_bf16(v[0], v[1]); w.y = cvt_pk_bf16(v[2], v[3]); w.z = cvt_pk_bf16(v[4], v[5]); w.w = cvt_pk_bf16(v[6], v[7]);
                        *(GAS u32x4*)((GAS bf16*)xb + off + bj * HALF) = w;
                        s += ((v[0] * v[0] + v[1] * v[1]) + (v[2] * v[2] + v[3] * v[3])) + ((v[4] * v[4] + v[5] * v[5]) + (v[6] * v[6] + v[7] * v[7])); } }
                if (!outf) { s += __shfl_xor(s, 16); s += __shfl_xor(s, 32);
                    if (fq == 0) (void)__hip_atomic_fetch_add((GAS u64*)rss + row0 + ai * HALF + m * 16, (u64)(s * 1048576.0f + 0.5f), __ATOMIC_RELAXED, __HIP_MEMORY_SCOPE_AGENT); } }
            asm volatile("" ::: "memory");
        }
    }
};
struct EpiBf16 {
    static constexpr bool PERM = true;
    struct Pre {};
    bf16* O0; int ldc0; bf16* O1; int ldc1; int pn_mask;
    __device__ __forceinline__ void prefetch(Pre&, const Unit&, int, int) const {}
    __device__ __forceinline__ void operator()(const f32x4 (&acc)[2][2][4][2], const Unit& u, const Pre&, int wr, int wc, int fr, int fq) const {
        bf16* O = u.sel ? O1 : O0; const int ldc = u.sel ? ldc1 : ldc0;
        const int row0 = u.pm * BM + wr * 64 + fr, col0 = (u.pn & pn_mask) * BM + wc * 32 + 8 * fq;
#pragma unroll
        for (int ai = 0; ai < 2; ++ai)
#pragma unroll
            for (int m = 0; m < 4; ++m) {
                GAS bf16* rowp = (GAS bf16*)O + (size_t)(row0 + ai * HALF + m * 16) * ldc + col0;
#pragma unroll
                for (int bj = 0; bj < 2; ++bj) { const f32x4 v0 = acc[ai][bj][m][0], v1 = acc[ai][bj][m][1];
                    u32x4 w; w.x = cvt_pk_bf16(v0[0], v0[1]); w.y = cvt_pk_bf16(v0[2], v0[3]); w.z = cvt_pk_bf16(v1[0], v1[1]); w.w = cvt_pk_bf16(v1[2], v1[3]);
                    *(GAS u32x4*)(rowp + bj * HALF) = w; }
            }
    }
};
struct EpiGLU {
    static constexpr bool PERM = true;
    struct Pre {};
    const bf16* Y; int ldy; bf16* O; int ldc;
    __device__ __forceinline__ void prefetch(Pre&, const Unit&, int, int) const {}
    __device__ __forceinline__ void operator()(const f32x4 (&acc)[2][2][4][2], const Unit& u, const Pre&, int wr, int wc, int fr, int fq) const {
        const int row0 = u.pm * BM + wr * 64 + fr, col0 = u.pn * BM + wc * 32 + 8 * fq;
#pragma unroll
        for (int ai = 0; ai < 2; ++ai)
#pragma unroll
            for (int m = 0; m < 4; ++m) {
                const size_t r = (size_t)(row0 + ai * HALF + m * 16);
#pragma unroll
                for (int bj = 0; bj < 2; ++bj) {
                    const u32x4 yv = *(const GAS u32x4*)((const GAS bf16*)Y + r * ldy + col0 + bj * HALF);
                    const f32x4 v0 = acc[ai][bj][m][0], v1 = acc[ai][bj][m][1];
                    f32x2 t2[4], o2[4];
#pragma unroll
                    for (int j = 0; j < 4; ++j) { const f32x2 aa = (j < 2) ? (f32x2){v0[2 * j], v0[2 * j + 1]} : (f32x2){v1[2 * j - 4], v1[2 * j - 3]}; t2[j] = aa * -1.4426950408889634f; }
#pragma unroll
                    for (int j = 0; j < 4; ++j) { t2[j].x = __builtin_amdgcn_exp2f(t2[j].x); t2[j].y = __builtin_amdgcn_exp2f(t2[j].y); }
#pragma unroll
                    for (int j = 0; j < 4; ++j) t2[j] = t2[j] + 1.0f;
#pragma unroll
                    for (int j = 0; j < 4; ++j) { t2[j].x = __builtin_amdgcn_rcpf(t2[j].x); t2[j].y = __builtin_amdgcn_rcpf(t2[j].y); }
#pragma unroll
                    for (int j = 0; j < 4; ++j) { const unsigned yw = yv[j]; o2[j] = (f32x2){__uint_as_float(yw << 16), __uint_as_float(yw & 0xffff0000u)} * t2[j]; }
                    u32x4 w; w.x = cvt_pk_bf16(o2[0].x, o2[0].y); w.y = cvt_pk_bf16(o2[1].x, o2[1].y); w.z = cvt_pk_bf16(o2[2].x, o2[2].y); w.w = cvt_pk_bf16(o2[3].x, o2[3].y);
                    *(GAS u32x4*)((GAS bf16*)O + r * ldc + col0 + bj * HALF) = w;
                }
            }
    }
};

template <class Epi, class Sched, bool ALIGN_EPI, bool SP2>
__device__ __forceinline__ void gemm_phase(LAS unsigned char* lds, const int K, const Sched& S, const Epi& E, const int tid) {
    const int wid = __builtin_amdgcn_readfirstlane(tid >> 6), lane = tid & 63, wr = wid >> 2, wc = wid & 3, fr = lane & 15, fq = lane >> 4;
    const int nt = K / BK;
    unsigned voffA[2], voffB[2];
#pragma unroll
    for (int i = 0; i < 2; ++i) { int R, C; stage_rc(tid * 16 + i * 8192, R, C); const int Rb = Epi::PERM ? ((R & ~31) + perm32(R & 31)) : R;
        voffA[i] = (unsigned)(R * K + C) * 2u; voffB[i] = (unsigned)(Rb * K + C) * 2u; }
    const size_t kstep = (size_t)(BK * 2);
    const size_t hstep = (size_t)HALF * K * 2;
    const unsigned ldsw = (unsigned)wid * 1024u;
    const int aoff = lds_byte(wr * 64 + fr, fq * 8), boff = lds_byte(wc * 32 + fr, fq * 8);
#define PG8_SA(b, h) (((b) * 2 + (h)) * HTB)
#define PG8_SB(b, h) ((4 + (b) * 2 + (h)) * HTB)
#define PG8_STAGE(bufoff, gbase, voff) do { _Pragma("unroll") for (int _i = 0; _i < 2; ++_i) \
        __builtin_amdgcn_global_load_lds((const unsigned*)((const char*)(gbase) + (voff)[_i]), (LAS unsigned*)(lds + (bufoff) + ldsw + _i * 8192), 16, 0, 0); } while (0)
#define PG8_LDA(dst, b, h) do { _Pragma("unroll") for (int m = 0; m < 4; ++m) _Pragma("unroll") for (int k = 0; k < 2; ++k) dst[m][k] = *(const LAS bf16x8*)(lds + PG8_SA(b, h) + aoff + m * 2048 + k * 1024); } while (0)
#define PG8_LDB(dst, b, h) do { _Pragma("unroll") for (int n = 0; n < 2; ++n) _Pragma("unroll") for (int k = 0; k < 2; ++k) dst[n][k] = *(const LAS bf16x8*)(lds + PG8_SB(b, h) + boff + n * 2048 + k * 1024); } while (0)
#define PG8_MMA(ai, bj, At, Bt) do { __builtin_amdgcn_s_setprio(1); _Pragma("unroll") for (int m = 0; m < 4; ++m) _Pragma("unroll") for (int n = 0; n < 2; ++n) _Pragma("unroll") for (int k = 0; k < 2; ++k) \
        acc[ai][bj][m][n] = __builtin_amdgcn_mfma_f32_16x16x32_bf16(Bt[n][k], At[m][k], acc[ai][bj][m][n], 0, 0, 0); __builtin_amdgcn_s_setprio(0); } while (0)
#define PG8_WAIT_V(n) asm volatile("s_waitcnt vmcnt(" #n ")" ::: "memory")
#define PG8_WAIT_L(n) asm volatile("s_waitcnt lgkmcnt(" #n ")" ::: "memory")
#define PG8_BAR __builtin_amdgcn_s_barrier()
#define PG8_SCHED __builtin_amdgcn_sched_barrier(0)
    Unit cur, nxt; int ui = 0;
    if (!S.next(0, cur)) return;
    f32x4 acc[2][2][4][2];
#pragma unroll
    for (int a = 0; a < 2; ++a)
#pragma unroll
        for (int b = 0; b < 2; ++b)
#pragma unroll
            for (int m = 0; m < 4; ++m)
#pragma unroll
                for (int n = 0; n < 2; ++n) acc[a][b][m][n] = (f32x4){0.f, 0.f, 0.f, 0.f};
    bf16x8 At[4][2], B0[2][2], B1[2][2];
    const char* cA = S.a_ptr(cur); const char* cB = S.b_ptr(cur);
    typename Epi::Pre pre; E.prefetch(pre, cur, wr, fr);
    if constexpr (SP2) {
        PG8_STAGE(PG8_SB(0, 0), cB, voffB); PG8_STAGE(PG8_SB(0, 1), cB + hstep, voffB); PG8_STAGE(PG8_SA(0, 0), cA, voffA); PG8_STAGE(PG8_SA(0, 1), cA + hstep, voffA);
        if (wr == 1) PG8_BAR;
        PG8_WAIT_V(2); PG8_BAR;
        PG8_STAGE(PG8_SB(1, 0), cB + kstep, voffB); PG8_STAGE(PG8_SA(1, 0), cA + kstep, voffA); PG8_STAGE(PG8_SB(1, 1), cB + hstep + kstep, voffB);
        PG8_WAIT_V(6); PG8_BAR;
    } else {
        PG8_STAGE(PG8_SB(0, 0), cB, voffB); PG8_STAGE(PG8_SA(0, 0), cA, voffA); PG8_STAGE(PG8_SB(0, 1), cB + hstep, voffB); PG8_STAGE(PG8_SA(0, 1), cA + hstep, voffA);
        if (wr == 1) PG8_BAR;
        PG8_WAIT_V(4); PG8_BAR;
        PG8_STAGE(PG8_SB(1, 0), cB + kstep, voffB); PG8_STAGE(PG8_SA(1, 0), cA + kstep, voffA); PG8_STAGE(PG8_SB(1, 1), cB + hstep + kstep, voffB);
        PG8_WAIT_V(6); PG8_BAR;
    }
    for (;;) {
        const bool has_next = S.next(ui + 1, nxt);
        const char* nA = has_next ? S.a_ptr(nxt) : cA; const char* nB = has_next ? S.b_ptr(nxt) : cB;
        for (int t = 0; t < nt; t += 2) {
            const bool last = (t == nt - 2);
            const char* a1 = cA + (size_t)(t + 1) * kstep;
            const char* a2 = last ? nA : cA + (size_t)(t + 2) * kstep; const char* b2 = last ? nB : cB + (size_t)(t + 2) * kstep;
            const char* a3 = a2 + kstep; const char* b3 = b2 + kstep;
            if constexpr (SP2) {
            PG8_LDB(B0, 0, 0); PG8_LDB(B1, 0, 1); PG8_SCHED; PG8_LDA(At, 0, 0); PG8_STAGE(PG8_SA(1, 1), a1 + hstep, voffA);
            PG8_WAIT_V(8); PG8_WAIT_L(0); PG8_BAR; PG8_MMA(0, 0, At, B0); PG8_MMA(0, 1, At, B1); PG8_BAR; PG8_SCHED;
            PG8_LDA(At, 0, 1); PG8_STAGE(PG8_SB(0, 0), b2, voffB); PG8_STAGE(PG8_SB(0, 1), b2 + hstep, voffB); PG8_STAGE(PG8_SA(0, 0), a2, voffA);
            PG8_WAIT_V(8); PG8_WAIT_L(0); PG8_BAR; PG8_MMA(1, 0, At, B0); PG8_MMA(1, 1, At, B1); PG8_BAR; PG8_SCHED;
            PG8_LDB(B0, 1, 0); PG8_LDB(B1, 1, 1); PG8_SCHED; PG8_LDA(At, 1, 0); PG8_STAGE(PG8_SA(0, 1), a2 + hstep, voffA);
            PG8_WAIT_V(8); PG8_WAIT_L(0); PG8_BAR; PG8_MMA(0, 0, At, B0); PG8_MMA(0, 1, At, B1); PG8_BAR; PG8_SCHED;
            PG8_LDA(At, 1, 1); PG8_STAGE(PG8_SB(1, 0), b3, voffB); PG8_STAGE(PG8_SB(1, 1), b3 + hstep, voffB); PG8_STAGE(PG8_SA(1, 0), a3, voffA);
            PG8_WAIT_V(8); PG8_WAIT_L(0); PG8_BAR; PG8_MMA(1, 0, At, B0); PG8_MMA(1, 1, At, B1); PG8_BAR; PG8_SCHED;
            } else {
            PG8_LDB(B0, 0, 0); PG8_SCHED; PG8_LDA(At, 0, 0); PG8_STAGE(PG8_SA(1, 1), a1 + hstep, voffA);
            PG8_WAIT_L(8); PG8_BAR; PG8_WAIT_L(0); PG8_MMA(0, 0, At, B0); PG8_BAR; PG8_SCHED;
            PG8_LDB(B1, 0, 1); PG8_STAGE(PG8_SB(0, 0), b2, voffB);
            PG8_BAR; PG8_WAIT_L(0); PG8_MMA(0, 1, At, B1); PG8_BAR;
            PG8_LDA(At, 0, 1); PG8_STAGE(PG8_SA(0, 0), a2, voffA);
            PG8_BAR; PG8_WAIT_L(0); PG8_MMA(1, 0, At, B0); PG8_BAR; PG8_SCHED;
            PG8_STAGE(PG8_SB(0, 1), b2 + hstep, voffB);
            PG8_WAIT_V(6); PG8_BAR; PG8_MMA(1, 1, At, B1); PG8_BAR;
            PG8_LDB(B0, 1, 0); PG8_SCHED; PG8_LDA(At, 1, 0); PG8_STAGE(PG8_SA(0, 1), a2 + hstep, voffA);
            PG8_WAIT_L(8); PG8_BAR; PG8_WAIT_L(0); PG8_MMA(0, 0, At, B0); PG8_BAR; PG8_SCHED;
            PG8_LDB(B1, 1, 1); PG8_STAGE(PG8_SB(1, 0), b3, voffB);
            PG8_BAR; PG8_WAIT_L(0); PG8_MMA(0, 1, At, B1); PG8_BAR;
            PG8_LDA(At, 1, 1); PG8_STAGE(PG8_SA(1, 0), a3, voffA);
            PG8_BAR; PG8_WAIT_L(0); PG8_MMA(1, 0, At, B0); PG8_BAR; PG8_SCHED;
            PG8_STAGE(PG8_SB(1, 1), b3 + hstep, voffB);
            PG8_WAIT_V(6); PG8_BAR; PG8_MMA(1, 1, At, B1); PG8_BAR;
            }
        }
        if constexpr (ALIGN_EPI) { if (wr == 0) PG8_BAR; }
        E(acc, cur, pre, wr, wc, fr, fq);
        if (!has_next) break;
#pragma unroll
        for (int a = 0; a < 2; ++a)
#pragma unroll
            for (int b = 0; b < 2; ++b)
#pragma unroll
                for (int m = 0; m < 4; ++m)
#pragma unroll
                    for (int n = 0; n < 2; ++n) acc[a][b][m][n] = (f32x4){0.f, 0.f, 0.f, 0.f};
        cur = nxt; cA = nA; cB = nB; ++ui;
        E.prefetch(pre, cur, wr, fr);
        if constexpr (ALIGN_EPI) { if (wr == 1) PG8_BAR; }
    }
    PG8_WAIT_V(0);
    if constexpr (!ALIGN_EPI) { if (wr == 0) PG8_BAR; }
    PG8_BAR;
#undef PG8_SA
#undef PG8_SB
#undef PG8_STAGE
#undef PG8_LDA
#undef PG8_LDB
#undef PG8_MMA
#undef PG8_WAIT_V
#undef PG8_WAIT_L
#undef PG8_BAR
#undef PG8_SCHED
}
}

typedef GAS unsigned gu32;
#define RLX_AGENT __ATOMIC_RELAXED, __HIP_MEMORY_SCOPE_AGENT
#define LDS_WAIT() asm volatile("s_waitcnt lgkmcnt(0)" ::: "memory")
#define VM_WAIT() asm volatile("s_waitcnt vmcnt(0)" ::: "memory")
__device__ __forceinline__ unsigned f2bf(float f) { unsigned u = __builtin_bit_cast(unsigned, f); return (u + 0x7fffu + ((u >> 16) & 1u)) >> 16; }
__device__ __forceinline__ unsigned pk2(float lo, float hi) { return pg8::cvt_pk_bf16(lo, hi); }
__device__ __forceinline__ float bf2f(unsigned short b) { return __uint_as_float(((unsigned)b) << 16); }
__device__ __forceinline__ f32x4 mfma16(bf16x8 a, bf16x8 b, f32x4 c) { return __builtin_amdgcn_mfma_f32_16x16x32_bf16(a, b, c, 0, 0, 0); }
using pg8::cvt_pk_bf16; using pg8::fexp; using pg8::flog; using pg8::fsigmoid;

#define XB_TMO      128
#define XB_XCNT(j)  (256  + 64 * (j))
#define XB_XSUB(j)  (1280 + 64 * (j))
#define XB_XGEN(j)  (2304 + 64 * (j))
#define XB_TOP      3328
#define XB_TOPGEN   3392
#define XCD_BAR_WORDS 3456
#define XB_SPIN_CAP (1u << 21)
__device__ __forceinline__ unsigned xb_ld(unsigned* p)              { return __hip_atomic_load(p, __ATOMIC_RELAXED, __HIP_MEMORY_SCOPE_AGENT); }
__device__ __forceinline__ unsigned xb_add(unsigned* p, unsigned v) { return __hip_atomic_fetch_add(p, v, __ATOMIC_RELAXED, __HIP_MEMORY_SCOPE_AGENT); }
__device__ __forceinline__ unsigned xb_xcc_id() { return (unsigned)__builtin_amdgcn_s_getreg((3 << 11) | 20) & 0xFu; }
#define XB_SPIN(cond, bar) do { unsigned _sp = 0; while (cond) { __builtin_amdgcn_s_sleep(1); \
    if ((++_sp & 255u) == 0u) { if (xb_ld(&(bar)[XB_TMO])) break; if (_sp > XB_SPIN_CAP) { atomicAdd(&(bar)[XB_TMO], 1u); break; } } } } while (0)
struct XcdBarrier { unsigned* bar; unsigned x; volatile LAS unsigned* st; };
__device__ __forceinline__ XcdBarrier xcd_barrier_post(unsigned* bar, volatile LAS unsigned* st) {
    XcdBarrier b; b.bar = bar; b.x = xb_xcc_id(); b.st = st;
    if (threadIdx.x == 0) (void)xb_add(&bar[XB_XCNT(b.x)], 1u);
    return b;
}
__device__ __forceinline__ void xcd_barrier_complete(unsigned* bar, unsigned x, unsigned& nloc, unsigned& nx) {
    const unsigned G = gridDim.x * gridDim.y * gridDim.z;
    unsigned sum, cnt, mine, sp = 0u;
    for (;;) {
        sum = 0u; cnt = 0u; mine = 0u;
#pragma unroll
        for (unsigned j = 0; j < 16; ++j) { const unsigned c = xb_ld(&bar[XB_XCNT(j)]); sum += c; cnt += (c > 0u) ? 1u : 0u; mine = (j == x) ? c : mine; }
        if (sum == G) break;
        __builtin_amdgcn_s_sleep(1);
        if ((++sp & 255u) == 0u) { if (xb_ld(&bar[XB_TMO])) break; if (sp > XB_SPIN_CAP) { atomicAdd(&bar[XB_TMO], 1u); break; } }
    }
    nloc = mine > 0u ? mine : 1u; nx = cnt > 0u ? cnt : 1u;
}
__device__ __forceinline__ void xcd_barrier(const XcdBarrier& b) {
    asm volatile("s_waitcnt vmcnt(0)" ::: "memory");
    __syncthreads();
    if (threadIdx.x == 0) {
        unsigned* bar = b.bar;
        __builtin_amdgcn_s_waitcnt(0);
        unsigned nloc = b.st[0], nx = b.st[1];
        if (nloc == 0u) { xcd_barrier_complete(bar, b.x, nloc, nx); b.st[0] = nloc; b.st[1] = nx; }
        const unsigned old = xb_add(&bar[XB_XSUB(b.x)], 1u);
        const unsigned gen = old / nloc;
        if (old + 1u == (gen + 1u) * nloc) {
            __builtin_amdgcn_fence(__ATOMIC_RELEASE, "agent");
            asm volatile("s_waitcnt vmcnt(0)" ::: "memory");
            const unsigned og = xb_add(&bar[XB_TOP], 1u);
            const unsigned tg = og / nx;
            if (og + 1u == (tg + 1u) * nx) xb_add(&bar[XB_TOPGEN], 1u);
            else XB_SPIN(xb_ld(&bar[XB_TOPGEN]) == tg, bar);
            __builtin_amdgcn_fence(__ATOMIC_ACQUIRE, "agent");
            xb_add(&bar[XB_XGEN(b.x)], 1u);
            asm volatile("s_waitcnt vmcnt(0)" ::: "memory");
        } else {
            XB_SPIN(xb_ld(&bar[XB_XGEN(b.x)]) == gen, bar);
            __builtin_amdgcn_fence(__ATOMIC_ACQUIRE, "agent");
            asm volatile("s_waitcnt vmcnt(0)" ::: "memory");
        }
    }
    __syncthreads();
}

__device__ __forceinline__ float wave_sum(float v) {
#pragma unroll
    for (int o = 1; o < 64; o <<= 1) v += __shfl_xor(v, o);
    return v;
}
__device__ __forceinline__ void transpose_item(const float* W, int K, int N, bf16* WT, int k0, int n0, int drow0, LAS float* scr, int lane, const float* gain = nullptr) {
    const int c = lane & 7, rq = lane >> 3;
    const GAS float* src = (const GAS float*)W + (size_t)(k0 + rq) * N + n0 + 4 * c;
    f32x4 v[8];
#pragma unroll
    for (int i = 0; i < 8; ++i) v[i] = *(const GAS f32x4*)(src + (size_t)(8 * i) * N);
    f32x4 g0 = (f32x4){1.f, 1.f, 1.f, 1.f}, g1 = g0;
    if (gain) { g0 = *(const GAS f32x4*)((const GAS float*)gain + k0 + 8 * c); g1 = *(const GAS f32x4*)((const GAS float*)gain + k0 + 8 * c + 4); }
#pragma unroll
    for (int i = 0; i < 8; ++i) { LAS float* d = scr + (8 * i + rq) * 33 + 4 * c; d[0] = v[i].x; d[1] = v[i].y; d[2] = v[i].z; d[3] = v[i].w; }
    LDS_WAIT(); asm volatile("" ::: "memory");
#pragma unroll
    for (int j = 0; j < 4; ++j) { const int n = rq + 8 * j; const LAS float* s = scr + (8 * c) * 33 + n;
        u32x4 o; o.x = pk2(s[0 * 33] * g0.x, s[1 * 33] * g0.y); o.y = pk2(s[2 * 33] * g0.z, s[3 * 33] * g0.w); o.z = pk2(s[4 * 33] * g1.x, s[5 * 33] * g1.y); o.w = pk2(s[6 * 33] * g1.z, s[7 * 33] * g1.w);
        *(GAS u32x4*)(WT + (size_t)(drow0 + n) * K + k0 + 8 * c) = o; }
    LDS_WAIT(); asm volatile("" ::: "memory");
}
__device__ __forceinline__ void rms_row_to_bf16(const float* xrow, const float* gain, bf16* orow, int lane) {
    const GAS f32x4* xr = (const GAS f32x4*)xrow + lane; const GAS f32x4* gr = (const GAS f32x4*)gain + lane;
    f32x4 v[8]; float s = 0.f;
#pragma unroll
    for (int j = 0; j < 8; ++j) { v[j] = xr[64 * j]; s += (v[j].x * v[j].x + v[j].y * v[j].y) + (v[j].z * v[j].z + v[j].w * v[j].w); }
    const float r = 1.0f / sqrtf(wave_sum(s) * (1.0f / DM) + EPS);
    GAS u32x2* o8 = (GAS u32x2*)orow + lane;
#pragma unroll
    for (int j = 0; j < 8; ++j) { const f32x4 g = gr[64 * j]; u32x2 w; w.x = pk2(v[j].x * r * g.x, v[j].y * r * g.y); w.y = pk2(v[j].z * r * g.z, v[j].w * r * g.w); o8[64 * j] = w; }
}

__device__ __forceinline__ double d_exp(double x) {
    const double k = __builtin_rint(x * 1.4426950408889634074); const double r = (x - k * 0.693147180369123816490) - k * 1.90821492927058770002e-10;
    double p = 1.0 / 6227020800.0;
    p = p * r + 1.0 / 479001600.0; p = p * r + 1.0 / 39916800.0; p = p * r + 1.0 / 3628800.0; p = p * r + 1.0 / 362880.0; p = p * r + 1.0 / 40320.0; p = p * r + 1.0 / 5040.0;
    p = p * r + 1.0 / 720.0; p = p * r + 1.0 / 120.0; p = p * r + 1.0 / 24.0; p = p * r + 1.0 / 6.0; p = p * r + 0.5; p = p * r + 1.0; p = p * r + 1.0;
    const long long ki = (long long)k; const double sc = __builtin_bit_cast(double, (unsigned long long)(ki + 1023) << 52);
    return p * sc;
}
__device__ __forceinline__ void d_sincos(double x, double& s, double& c) {
    const double k = __builtin_rint(x * 0.63661977236758134308); const double r = (x - k * 1.57079632673412561417) - k * 6.07710050650619224932e-11;
    const double r2 = r * r;
    double ps = -1.0 / 121645100408832000.0;
    ps = ps * r2 + 1.0 / 355687428096000.0; ps = ps * r2 - 1.0 / 1307674368000.0; ps = ps * r2 + 1.0 / 6227020800.0; ps = ps * r2 - 1.0 / 39916800.0; ps = ps * r2 + 1.0 / 362880.0;
    ps = ps * r2 - 1.0 / 5040.0; ps = ps * r2 + 1.0 / 120.0; ps = ps * r2 - 1.0 / 6.0; ps = ps * r2 + 1.0; ps = ps * r;
    double pc = 1.0 / 6402373705728000.0;
    pc = -pc; pc = pc * r2 + 1.0 / 20922789888000.0; pc = pc * r2 - 1.0 / 87178291200.0; pc = pc * r2 + 1.0 / 479001600.0; pc = pc * r2 - 1.0 / 3628800.0; pc = pc * r2 + 1.0 / 40320.0;
    pc = pc * r2 - 1.0 / 720.0; pc = pc * r2 + 1.0 / 24.0; pc = pc * r2 - 0.5; pc = pc * r2 + 1.0;
    const int q = ((int)k) & 3;
    s = (q == 0) ? ps : (q == 1) ? pc : (q == 2) ? -ps : -pc;
    c = (q == 0) ? pc : (q == 1) ? -ps : (q == 2) ? -pc : ps;
}

__device__ __forceinline__ void sb_attn_wave(const bf16* PROJ_, const bf16* VT_, bf16* TOK_, const float* rk_, int b, int h, int qt2, int lane, LAS unsigned char* stg) {
    const GAS bf16* PROJ = (const GAS bf16*)PROJ_; const GAS bf16* VT = (const GAS bf16*)VT_; GAS bf16* TOK = (GAS bf16*)TOK_;
    const GAS float* RK = (const GAS float*)rk_ + (size_t)b * SEQ;
    const int fr = lane & 15, fq = lane >> 4;
    const int t0 = qt2 * 32;
    const size_t rowbase = (size_t)b * SEQ;
    bf16x8 qf[2][4]; float scl[2]; int tq[2];
#pragma unroll
    for (int qi = 0; qi < 2; ++qi) { tq[qi] = t0 + 16 * qi + fr;
        const GAS bf16* qp = PROJ + (rowbase + tq[qi]) * PROJ_SB + h * HD + 8 * fq;
#pragma unroll
        for (int ks = 0; ks < 4; ++ks) qf[qi][ks] = *(const GAS bf16x8*)(qp + 32 * ks);
        scl[qi] = (0.08838834764831845f * 1.4426950408889634f) * RK[tq[qi]]; }
    f32x4 o[2][8];
#pragma unroll
    for (int qi = 0; qi < 2; ++qi)
#pragma unroll
        for (int dt = 0; dt < 8; ++dt) o[qi][dt] = (f32x4){0.f, 0.f, 0.f, 0.f};
    float C[2] = {0.f, 0.f};
    const GAS bf16* kbase = PROJ + (rowbase + 8 * (fr >> 2) + (fr & 3)) * PROJ_SB + TOKW + h * HD + 8 * fq;
    const GAS bf16* vbase = VT + (size_t)(h * HD + fr) * M + rowbase + 8 * fq;
#pragma unroll 1
    for (int kp = t0 >> 5; kp >= 0; --kp) {
        const int kb = kp * 32;
        f32x4 s[2][2];
#pragma unroll
        for (int qi = 0; qi < 2; ++qi) { s[qi][0] = (f32x4){0.f, 0.f, 0.f, 0.f}; s[qi][1] = (f32x4){0.f, 0.f, 0.f, 0.f}; }
        const GAS bf16* k0p = kbase + (size_t)kb * PROJ_SB; const GAS bf16* k1p = k0p + (size_t)4 * PROJ_SB;
#pragma unroll
        for (int ks = 0; ks < 4; ++ks) { const bf16x8 k0 = *(const GAS bf16x8*)(k0p + 32 * ks), k1 = *(const GAS bf16x8*)(k1p + 32 * ks);
#pragma unroll
            for (int qi = 0; qi < 2; ++qi) { s[qi][0] = mfma16(k0, qf[qi][ks], s[qi][0]); s[qi][1] = mfma16(k1, qf[qi][ks], s[qi][1]); } }
        bf16x8 vf[8];
#pragma unroll
        for (int dt = 0; dt < 8; ++dt) vf[dt] = *(const GAS bf16x8*)(vbase + (size_t)(16 * dt) * M + kb);
        float rk[2][4];
        { const f32x4 r0 = *(const GAS f32x4*)(RK + kb + 8 * fq), r1 = *(const GAS f32x4*)(RK + kb + 8 * fq + 4);
#pragma unroll
          for (int r = 0; r < 4; ++r) { rk[0][r] = r0[r]; rk[1][r] = r1[r]; } }
#pragma unroll
        for (int qi = 0; qi < 2; ++qi) {
            float ln[2][4], zz[2][4]; bool valid[2][4];
#pragma unroll
            for (int T = 0; T < 2; ++T)
#pragma unroll
                for (int r = 0; r < 4; ++r) { const float z = s[qi][T][r] * scl[qi] * rk[T][r]; valid[T][r] = (kb + 8 * fq + 4 * T + r) < tq[qi];
                    const float e = __builtin_amdgcn_exp2f(-fabsf(z)); const float sp = fmaxf(z, 0.f) + __builtin_amdgcn_logf(1.0f + e);
                    ln[T][r] = valid[T][r] ? -sp : 0.f; zz[T][r] = z; }
            float suf[2][4], tot[2];
#pragma unroll
            for (int T = 0; T < 2; ++T) { suf[T][3] = 0.f; suf[T][2] = ln[T][3]; suf[T][1] = ln[T][3] + ln[T][2]; suf[T][0] = suf[T][1] + ln[T][1]; tot[T] = suf[T][0] + ln[T][0]; }
            const float lt = tot[0] + tot[1];
            const float t1 = __shfl_down(lt, 16), t2 = __shfl_down(lt, 32), t3 = __shfl_down(lt, 48);
            const float higher = (fq < 3 ? t1 : 0.f) + (fq < 2 ? t2 : 0.f) + (fq < 1 ? t3 : 0.f);
            float ta = lt + __shfl_xor(lt, 16); ta += __shfl_xor(ta, 32);
            const float base1 = C[qi] + higher, base0 = base1 + tot[1];
            float w[2][4];
#pragma unroll
            for (int r = 0; r < 4; ++r) { w[0][r] = valid[0][r] ? __builtin_amdgcn_exp2f(zz[0][r] + ln[0][r] + base0 + suf[0][r]) * rk[0][r] : 0.f;
                                          w[1][r] = valid[1][r] ? __builtin_amdgcn_exp2f(zz[1][r] + ln[1][r] + base1 + suf[1][r]) * rk[1][r] : 0.f; }
            C[qi] += ta;
            union { bf16x8 v; unsigned u[4]; } pf;
            pf.u[0] = cvt_pk_bf16(w[0][0], w[0][1]); pf.u[1] = cvt_pk_bf16(w[0][2], w[0][3]); pf.u[2] = cvt_pk_bf16(w[1][0], w[1][1]); pf.u[3] = cvt_pk_bf16(w[1][2], w[1][3]);
#pragma unroll
            for (int dt = 0; dt < 8; ++dt) o[qi][dt] = mfma16(vf[dt], pf.v, o[qi][dt]);
        }
        if (__all(C[0] < -57.70780163555854f && C[1] < -57.70780163555854f)) break;
    }
#pragma unroll
    for (int qi = 0; qi < 2; ++qi) { LAS unsigned char* sp = stg + (16 * qi + fr) * 272 + 8 * fq;
#pragma unroll
        for (int dt = 0; dt < 8; ++dt) { u32x2 w; w.x = cvt_pk_bf16(o[qi][dt][0], o[qi][dt][1]); w.y = cvt_pk_bf16(o[qi][dt][2], o[qi][dt][3]); *(LAS u32x2*)(sp + 32 * dt) = w; } }
    {
        u32x4 w[8];
#pragma unroll
        for (int i = 0; i < 8; ++i) w[i] = *(LAS u32x4*)(stg + (4 * i + fq) * 272 + 16 * fr);
        GAS bf16* op = TOK + (rowbase + t0 + fq) * DM + h * HD + 8 * fr;
#pragma unroll
        for (int i = 0; i < 8; ++i) *(GAS u32x4*)(op + (size_t)(4 * i) * DM) = w[i];
    }
}

__device__ __forceinline__ void cross_attn_wave(const bf16* PROJ_, int ldp, int qoff, LAS unsigned char* lds, bf16* TOK_, const u64* rss_, int b, int hm, int qt2, int lane) {
    const GAS bf16* PROJ = (const GAS bf16*)PROJ_; GAS bf16* TOK = (GAS bf16*)TOK_;
    const int fr = lane & 15, fq = lane >> 4;
    bf16x8 qf[2][4]; float rq[2]; size_t row[2];
#pragma unroll
    for (int qi = 0; qi < 2; ++qi) { row[qi] = (size_t)b * SEQ + qt2 * 32 + 16 * qi + fr; float ss = 0.f;
        const GAS bf16* qp = PROJ + row[qi] * ldp + qoff + hm * HD + 8 * fq;
#pragma unroll
        for (int ks = 0; ks < 4; ++ks) { qf[qi][ks] = *(const GAS bf16x8*)(qp + 32 * ks);
#pragma unroll
            for (int j = 0; j < 8; ++j) { const float q = bf2f((unsigned short)qf[qi][ks][j]); ss += q * q; } }
        ss += __shfl_xor(ss, 16); ss += __shfl_xor(ss, 32);
        const float eps2 = EPS * (rss2f(((const GAS u64*)rss_)[row[qi]]) * (1.0f / DM) + EPS);
        rq[qi] = (1.0f / sqrtf(ss * (1.0f / HD) + eps2)) * (0.08838834764831845f * 1.4426950408889634f); }
    f32x4 o[2][8];
#pragma unroll
    for (int qi = 0; qi < 2; ++qi)
#pragma unroll
        for (int dt = 0; dt < 8; ++dt) o[qi][dt] = (f32x4){0.f, 0.f, 0.f, 0.f};
    float mrun[2] = {-1e30f, -1e30f}, lrun[2] = {0.f, 0.f};
    LAS unsigned char* kbase = lds + (8 * (fr >> 2) + (fr & 3)) * XK_ROWB + 16 * fq;
    LAS unsigned char* vbase = lds + XV_OFF + fr * XV_ROWB + 16 * fq;
#pragma unroll 1
    for (int kp = 0; kp < 8; ++kp) {
        const int kb = kp * 32;
        f32x4 s[2][2];
#pragma unroll
        for (int qi = 0; qi < 2; ++qi) { s[qi][0] = (f32x4){0.f, 0.f, 0.f, 0.f}; s[qi][1] = (f32x4){0.f, 0.f, 0.f, 0.f}; }
#pragma unroll
        for (int ks = 0; ks < 4; ++ks) { const bf16x8 k0 = *(const LAS bf16x8*)(kbase + kb * XK_ROWB + 64 * ks), k1 = *(const LAS bf16x8*)(kbase + (kb + 4) * XK_ROWB + 64 * ks);
#pragma unroll
            for (int qi = 0; qi < 2; ++qi) { s[qi][0] = mfma16(k0, qf[qi][ks], s[qi][0]); s[qi][1] = mfma16(k1, qf[qi][ks], s[qi][1]); } }
        bf16x8 vf[8];
#pragma unroll
        for (int dt = 0; dt < 8; ++dt) vf[dt] = *(const LAS bf16x8*)(vbase + 16 * dt * XV_ROWB + 2 * kb);
#pragma unroll
        for (int qi = 0; qi < 2; ++qi) {
            float mx = -1e30f;
#pragma unroll
            for (int r = 0; r < 4; ++r) { s[qi][0][r] *= rq[qi]; s[qi][1][r] *= rq[qi]; mx = fmaxf(mx, fmaxf(s[qi][0][r], s[qi][1][r])); }
            mx = fmaxf(mx, __shfl_xor(mx, 16)); mx = fmaxf(mx, __shfl_xor(mx, 32));
            if (__any(mx > mrun[qi] + 8.0f)) {
                const float mnew = fmaxf(mrun[qi], mx), corr = __builtin_amdgcn_exp2f(mrun[qi] - mnew);
#pragma unroll
                for (int dt = 0; dt < 8; ++dt) o[qi][dt] = o[qi][dt] * corr;
                lrun[qi] *= corr; mrun[qi] = mnew; }
            const float mref = mrun[qi];
            float p0[4], p1[4], ps = 0.f;
#pragma unroll
            for (int r = 0; r < 4; ++r) { p0[r] = __builtin_amdgcn_exp2f(s[qi][0][r] - mref); p1[r] = __builtin_amdgcn_exp2f(s[qi][1][r] - mref); ps += p0[r] + p1[r]; }
            ps += __shfl_xor(ps, 16); ps += __shfl_xor(ps, 32);
            lrun[qi] += ps;
            union { bf16x8 v; unsigned u[4]; } pf;
            pf.u[0] = cvt_pk_bf16(p0[0], p0[1]); pf.u[1] = cvt_pk_bf16(p0[2], p0[3]); pf.u[2] = cvt_pk_bf16(p1[0], p1[1]); pf.u[3] = cvt_pk_bf16(p1[2], p1[3]);
#pragma unroll
            for (int dt = 0; dt < 8; ++dt) o[qi][dt] = mfma16(vf[dt], pf.v, o[qi][dt]);
        }
    }
#pragma unroll
    for (int qi = 0; qi < 2; ++qi) { const float inv = 1.0f / lrun[qi];
        GAS bf16* op = TOK + row[qi] * DM + TOKW + hm * HD + 4 * fq;
#pragma unroll
        for (int dt = 0; dt < 8; ++dt) { u32x2 w; w.x = cvt_pk_bf16(o[qi][dt][0] * inv, o[qi][dt][1] * inv); w.y = cvt_pk_bf16(o[qi][dt][2] * inv, o[qi][dt][3] * inv); *(GAS u32x2*)(op + 16 * dt) = w; } }
}

constexpr int S5_LDS_WAVE = 12800;
template <int PASS>
__device__ __forceinline__ void s5_wave(const bf16* PROJ_, const bf16* Bbar_, const bf16* Ccat_, const float* ABAR_, const float* dskip_, float* E_, bf16* Y_, const u64* rss_,
                                        int b, int g, int c, LAS unsigned char* wl, int lane) {
    const GAS bf16* PROJ = (const GAS bf16*)PROJ_; const GAS bf16* Bbar = (const GAS bf16*)Bbar_; const GAS bf16* Ccat = (const GAS bf16*)Ccat_;
    const GAS float* ABAR = (const GAS float*)ABAR_; const GAS float* dskip = (const GAS float*)dskip_; GAS float* E = (GAS float*)E_; GAS bf16* Y = (GAS bf16*)Y_;
    const int fr = lane & 15, fq = lane >> 4;
    LAS float* BUs = (LAS float*)wl; LAS bf16* Ss = (LAS bf16*)(wl + 8448);
    const bf16x8 zero8 = (bf16x8){0, 0, 0, 0, 0, 0, 0, 0};
    const size_t row0 = (size_t)b * SEQ + (size_t)c * S5T;
    const GAS bf16* up = PROJ + (row0 + fr) * PROJ_S5 + g * 16;
    const GAS u64* RS = (const GAS u64*)rss_ + row0 + fr;
    bf16x8 ufn = *(const GAS bf16x8*)(up + 8 * (fq & 1)); bf16x4 u4n = *(const GAS bf16x4*)(up + 4 * fq); u64 rsn = RS[0];
    bf16x8 bb[8];
#pragma unroll
    for (int mt = 0; mt < 8; ++mt) { const bf16x8 t = *(const GAS bf16x8*)(Bbar + ((size_t)g * 128 + 16 * mt + fr) * 16 + 8 * (fq & 1)); bb[mt] = (fq < 2) ? t : zero8; }
    const f32x4 ab = *(const GAS f32x4*)(ABAR + ((size_t)g * 64 + lane) * 4);
    bf16x8 cc[4]; f32x4 dv = (f32x4){0.f, 0.f, 0.f, 0.f};
    if (PASS == 1) {
#pragma unroll
        for (int ks = 0; ks < 4; ++ks) cc[ks] = *(const GAS bf16x8*)(Ccat + ((size_t)g * 16 + fr) * 128 + 32 * ks + 8 * fq);
        dv = *(const GAS f32x4*)(dskip + g * 16 + 4 * fq);
    }
    float sre = 0.f, sim = 0.f;
    const f32x2 a00 = (f32x2){ab[0], ab[0]}, a11 = (f32x2){-ab[1], ab[1]};
    GAS float* Ebg = E + ((size_t)(b * S5G + g) * S5NC) * 128;
    if (PASS == 1) {
        int jc = 0;
#pragma unroll 1
        for (; jc + 8 <= c; jc += 8) { f32x2 e[8];
#pragma unroll
            for (int k = 0; k < 8; ++k) e[k] = *(const GAS f32x2*)(Ebg + (size_t)(jc + k) * 128 + 2 * lane);
#pragma unroll
            for (int k = 0; k < 8; ++k) { const float nre = ab[2] * sre - ab[3] * sim + e[k].x, nim = ab[2] * sim + ab[3] * sre + e[k].y; sre = nre; sim = nim; } }
#pragma unroll 1
        for (; jc < c; ++jc) { const f32x2 e = *(const GAS f32x2*)(Ebg + (size_t)jc * 128 + 2 * lane);
            const float nre = ab[2] * sre - ab[3] * sim + e.x, nim = ab[2] * sim + ab[3] * sre + e.y; sre = nre; sim = nim; }
    }
#pragma unroll 1
    for (int sb = 0; sb < S5T / 16; ++sb) {
          const bf16x8 uf = ufn; const bf16x4 u4 = u4n; const float rt = __builtin_amdgcn_rsqf(rss2f(rsn) * (1.0f / DM) + EPS);
        if (sb < S5T / 16 - 1) { const GAS bf16* un = up + (size_t)(sb + 1) * 16 * PROJ_S5;
            ufn = *(const GAS bf16x8*)(un + 8 * (fq & 1)); u4n = *(const GAS bf16x4*)(un + 4 * fq); rsn = RS[(sb + 1) * 16]; }
#pragma unroll
        for (int mt = 0; mt < 8; ++mt) { const f32x4 bu = mfma16(bb[mt], uf, (f32x4){0.f, 0.f, 0.f, 0.f}) * rt;
            *(LAS f32x4*)(BUs + fr * 132 + 16 * mt + 4 * fq) = bu; }
        LDS_WAIT(); asm volatile("" ::: "memory");
        f32x2 bt[16];
#pragma unroll
        for (int t = 0; t < 16; ++t) bt[t] = *(const LAS f32x2*)(BUs + t * 132 + 2 * lane);
        LDS_WAIT(); asm volatile("" ::: "memory");
        f32x2 sv = (f32x2){sre, sim};
#pragma unroll
        for (int t = 0; t < 16; ++t) {
            f32x2 tt, s2;
            asm("v_pk_fma_f32 %0, %1, %2, %3" : "=v"(tt) : "v"(a00), "v"(sv), "v"(bt[t]));
            asm("v_pk_fma_f32 %0, %1, %2, %3 op_sel:[0,1,0] op_sel_hi:[1,0,1]" : "=v"(s2) : "v"(a11), "v"(sv), "v"(tt));
            sv = s2;
            if (PASS == 1) *(LAS unsigned*)(Ss + t * 136 + 2 * lane) = cvt_pk_bf16(sv.x, sv.y); }
        sre = sv.x; sim = sv.y;
        if (PASS == 1) {
            LDS_WAIT(); asm volatile("" ::: "memory");
            f32x4 y = (f32x4){0.f, 0.f, 0.f, 0.f};
#pragma unroll
            for (int ks = 0; ks < 4; ++ks) { const bf16x8 sf = *(const LAS bf16x8*)(Ss + fr * 136 + 32 * ks + 8 * fq); y = mfma16(cc[ks], sf, y); }
            float ov[4];
#pragma unroll
            for (int r = 0; r < 4; ++r) { const float v = y[r] + dv[r] * (bf2f((unsigned short)u4[r]) * rt);
                const float uu = 0.7978845608028654f * (v + 0.044715f * v * v * v); ov[r] = v * fsigmoid(2.0f * uu); }
            u32x2 w; w.x = cvt_pk_bf16(ov[0], ov[1]); w.y = cvt_pk_bf16(ov[2], ov[3]);
            *(GAS u32x2*)(Y + (row0 + sb * 16 + fr) * TOKW + g * 16 + 4 * fq) = w;
        }
        LDS_WAIT(); asm volatile("" ::: "memory");
        __builtin_amdgcn_sched_barrier(0);
        asm volatile("" : "+v"(ufn), "+v"(u4n), "+v"(rsn));
    }
    if (PASS == 0) *(GAS f32x2*)(Ebg + (size_t)c * 128 + 2 * lane) = (f32x2){sre, sim};
}

__device__ __forceinline__ void s5_pass0_wave(const bf16* PROJ_, const bf16* Bbar_, const float* ABAR_, float* E_, const u64* rss_, int b, int g, int c, LAS unsigned char* wl, int lane) {
    const GAS bf16* PROJ = (const GAS bf16*)PROJ_; const GAS bf16* Bbar = (const GAS bf16*)Bbar_; const GAS float* ABAR = (const GAS float*)ABAR_; GAS float* E = (GAS float*)E_;
    const int fr = lane & 15, fq = lane >> 4;
    const bf16x8 zero8 = (bf16x8){0, 0, 0, 0, 0, 0, 0, 0};
    const size_t row0 = (size_t)b * SEQ + (size_t)c * S5T;
    const GAS bf16* up = PROJ + (row0 + fr) * PROJ_S5 + g * 16 + 8 * (fq & 1);
    bf16x8 ufn[4];
#pragma unroll
    for (int i = 0; i < 4; ++i) ufn[i] = *(const GAS bf16x8*)(up + (size_t)i * 16 * PROJ_S5);
    LAS float* rtl = (LAS float*)wl;
    {
        const GAS u64* RS = (const GAS u64*)rss_ + row0 + 4 * lane;
        const u64 r0 = RS[0], r1 = RS[1], r2 = RS[2], r3 = RS[3];
        f32x4 rv; rv[0] = __builtin_amdgcn_rsqf(rss2f(r0) * (1.0f / DM) + EPS); rv[1] = __builtin_amdgcn_rsqf(rss2f(r1) * (1.0f / DM) + EPS);
        rv[2] = __builtin_amdgcn_rsqf(rss2f(r2) * (1.0f / DM) + EPS); rv[3] = __builtin_amdgcn_rsqf(rss2f(r3) * (1.0f / DM) + EPS);
        *(LAS f32x4*)(rtl + 4 * lane) = rv;
    }
    bf16x8 bre[4], bim[4];
    float are[4], aim[4], gre[4], gim[4];
#pragma unroll
    for (int j = 0; j < 4; ++j) { const GAS bf16* bp = Bbar + ((size_t)g * 128 + 2 * (16 * j + fr)) * 16 + 8 * (fq & 1);
        const bf16x8 t0 = *(const GAS bf16x8*)bp, t1 = *(const GAS bf16x8*)(bp + 16); bre[j] = (fq < 2) ? t0 : zero8; bim[j] = (fq < 2) ? t1 : zero8;
        const f32x2 a = *(const GAS f32x2*)(ABAR + ((size_t)g * 64 + 16 * j + fr) * 4);
        are[j] = a.x; aim[j] = a.y;
        const float a2r = a.x * a.x - a.y * a.y, a2i = 2.0f * a.x * a.y;
        const float a4r = a2r * a2r - a2i * a2i, a4i = 2.0f * a2r * a2i;
        const float a8r = a4r * a4r - a4i * a4i, a8i = 2.0f * a4r * a4i;
        const float a12r = a8r * a4r - a8i * a4i, a12i = a8r * a4i + a8i * a4r;
        gre[j] = a12r * a.x - a12i * a.y; gim[j] = a12r * a.y + a12i * a.x; }
    float Rre[4] = {0.f, 0.f, 0.f, 0.f}, Rim[4] = {0.f, 0.f, 0.f, 0.f};
    LDS_WAIT(); asm volatile("" ::: "memory");
#pragma unroll 1
    for (int h = 0; h < S5T / 64; ++h) {
      bf16x8 ufc[4];
#pragma unroll
      for (int i = 0; i < 4; ++i) ufc[i] = ufn[i];
      if (h < S5T / 64 - 1) {
#pragma unroll
          for (int i = 0; i < 4; ++i) ufn[i] = *(const GAS bf16x8*)(up + (size_t)((h + 1) * 4 + i) * 16 * PROJ_S5); }
#pragma unroll
      for (int i = 0; i < 4; ++i) { const int sb = h * 4 + i;
        const bf16x8 uf = ufc[i];
        const f32x4 rt = *(const LAS f32x4*)(rtl + 16 * sb + 4 * fq);
#pragma unroll
        for (int j = 0; j < 4; ++j) {
            const f32x4 br = mfma16(uf, bre[j], (f32x4){0.f, 0.f, 0.f, 0.f}) * rt, bi = mfma16(uf, bim[j], (f32x4){0.f, 0.f, 0.f, 0.f}) * rt;
            float nr = __builtin_fmaf(-gim[j], Rim[j], __builtin_fmaf(gre[j], Rre[j], br[0])), ni = __builtin_fmaf(gim[j], Rre[j], __builtin_fmaf(gre[j], Rim[j], bi[0]));
#pragma unroll
            for (int r = 1; r < 4; ++r) { const float tr = __builtin_fmaf(-aim[j], ni, __builtin_fmaf(are[j], nr, br[r])), ti = __builtin_fmaf(aim[j], nr, __builtin_fmaf(are[j], ni, bi[r])); nr = tr; ni = ti; }
            Rre[j] = nr; Rim[j] = ni; }
        __builtin_amdgcn_sched_barrier(0);
      }
      asm volatile("" : "+v"(ufn[0]), "+v"(ufn[1]), "+v"(ufn[2]), "+v"(ufn[3]));
    }
    float ore = 0.f, oim = 0.f;
#pragma unroll
    for (int j = 0; j < 4; ++j) {
        const float a2r = are[j] * are[j] - aim[j] * aim[j], a2i = 2.0f * are[j] * aim[j];
        const float a4r = a2r * a2r - a2i * a2i, a4i = 2.0f * a2r * a2i;
        const float a8r = a4r * a4r - a4i * a4i, a8i = 2.0f * a4r * a4i;
        const float a12r = a8r * a4r - a8i * a4i, a12i = a8r * a4i + a8i * a4r;
        const float wr = fq == 0 ? a12r : fq == 1 ? a8r : fq == 2 ? a4r : 1.0f, wi = fq == 0 ? a12i : fq == 1 ? a8i : fq == 2 ? a4i : 0.0f;
        float xr = wr * Rre[j] - wi * Rim[j], xi = wr * Rim[j] + wi * Rre[j];
        xr += __shfl_xor(xr, 16); xi += __shfl_xor(xi, 16); xr += __shfl_xor(xr, 32); xi += __shfl_xor(xi, 32);
        if (fq == j) { ore = xr; oim = xi; } }
    *(GAS f32x2*)(E + ((size_t)(b * S5G + g) * S5NC + c) * 128 + 2 * lane) = (f32x2){ore, oim};
}

struct Args { const float* in[25]; float* out; unsigned char* ws; };
enum { I_X = 0, I_MEM, I_F1N, I_F1GU, I_F1DN, I_MIXN, I_MEMN, I_WKV, I_XQN, I_XKN, I_WOUT, I_F2N, I_F2GU, I_F2DN, I_SBIN, I_S5IN, I_LOGDT, I_ARE, I_AIM, I_BRE, I_BIM, I_CRE, I_CIM, I_S5D, I_WGLU };

__device__ __forceinline__ void cross_attn_phase(const bf16* PROJ, int ldp, int qoff, const bf16* KNl, const bf16* VTMl, bf16* TOK, const u64* rss, LAS unsigned char* lds, int vcu, int G, int tid, int wave, int lane) {
#pragma unroll 1
    for (int base = vcu * 8; base < BATCH * MEMHEADS * (SEQ / 32); base += G * 8) {
        const int bh = base >> 8;
        const GAS bf16* kn = (const GAS bf16*)KNl + (size_t)bh * NMEM * HD; const GAS bf16* vt = (const GAS bf16*)VTMl + (size_t)bh * HD * NMEM;
        __syncthreads();
        { u32x4 kv[8], vv[8];
#pragma unroll
          for (int it = 0; it < 8; ++it) { const int ch = tid + 512 * it; kv[it] = *(const GAS u32x4*)(kn + (size_t)(ch >> 4) * HD + 8 * (ch & 15)); vv[it] = *(const GAS u32x4*)(vt + (size_t)(ch >> 5) * NMEM + 8 * (ch & 31)); }
#pragma unroll
          for (int it = 0; it < 8; ++it) { const int ch = tid + 512 * it; *(LAS u32x4*)(lds + (ch >> 4) * XK_ROWB + 16 * (ch & 15)) = kv[it]; *(LAS u32x4*)(lds + XV_OFF + (ch >> 5) * XV_ROWB + 16 * (ch & 31)) = vv[it]; } }
        asm volatile("s_waitcnt vmcnt(0) lgkmcnt(0)" ::: "memory"); __syncthreads();
        const int v = base + wave; cross_attn_wave(PROJ, ldp, qoff, lds, TOK, rss, bh / MEMHEADS, bh % MEMHEADS, v & 255, lane);
    }
    __syncthreads();
}

#define PHASE_VARS \
    int ptid = threadIdx.x; asm volatile("" : "+v"(ptid)); \
    const int lane = ptid & 63; const int wave = __builtin_amdgcn_readfirstlane(ptid >> 6); \
    const int gw = vcu * 8 + wave; \
    unsigned char* ws = args.ws; asm volatile("" : "+s"(ws)); \
    float* out = args.out; asm volatile("" : "+s"(out)); \
    (void)lane; (void)gw; (void)out;
#define P_WGU1 ((bf16*)(ws + WS_WGU1))
#define P_WDN1 ((bf16*)(ws + WS_WDN1))
#define P_WGU2 ((bf16*)(ws + WS_WGU2))
#define P_WDN2 ((bf16*)(ws + WS_WDN2))
#define P_WOUT ((bf16*)(ws + WS_WOUT))
#define P_WKV ((bf16*)(ws + WS_WKV))
#define P_WINSB ((bf16*)(ws + WS_WINSB))
#define P_WINS5 ((bf16*)(ws + WS_WINS5))
#define P_WGLU ((bf16*)(ws + WS_WGLU))
#define P_XN ((bf16*)(ws + WS_XN))
#define P_ACT ((bf16*)(ws + WS_ACT))
#define P_PROJ ((bf16*)(ws + WS_PROJ))
#define P_VT ((bf16*)(ws + WS_VT))
#define P_YB ((bf16*)(ws + WS_VT))
#define P_TOK ((bf16*)(ws + WS_TOK))
#define P_MEMH ((bf16*)(ws + WS_MEMH))
#define P_KVM ((bf16*)(ws + WS_KVM))
#define P_KN ((bf16*)(ws + WS_KN))
#define P_VTM ((bf16*)(ws + WS_VTM))
#define P_BBAR ((bf16*)(ws + WS_BBAR))
#define P_CCAT ((bf16*)(ws + WS_CCAT))
#define P_ABAR ((float*)(ws + WS_ABAR))
#define P_EB ((float*)(ws + WS_E))
#define P_RSS ((u64*)(ws + WS_RSS))

__global__ void __launch_bounds__(512, 2) fwd(Args args) {
    extern __shared__ __attribute__((aligned(16))) unsigned char lds_raw[];
    LAS unsigned char* lds = (LAS unsigned char*)lds_raw;
    const int G = gridDim.x; const int bx = blockIdx.x; const int vcu = (G % 8 == 0) ? (bx % 8) * (G / 8) + bx / 8 : bx;
    const int NGW = G * 8;
    for (int u = threadIdx.x; u < (LDS_BYTES - LDSCTL_OFF) / 4; u += 512) ((LAS unsigned*)(lds + LDSCTL_OFF))[u] = 0u;
    __syncthreads();
    XcdBarrier bar = xcd_barrier_post((unsigned*)(args.ws + WS_CTL) + CW_BAR, (volatile LAS unsigned*)(lds + MISC_OFF) + 8);
#define GRID_BAR() xcd_barrier(bar)

    {
        PHASE_VARS
        LAS float* scr = (LAS float*)(lds + wave * 16384);
        constexpr int IT_GU = (DM / 64) * (2 * FFN / 32), IT_DN = (FFN / 64) * (DM / 32), IT_OUT = (DM / 64) * (DM / 32), IT_KV = (DM / 64) * (1024 / 32);
        constexpr int IT_INSB = (DM / 64) * (5120 / 32), IT_INS5 = (DM / 64) * (DM / 32), IT_GLU = (TOKW / 64) * (TOKW / 32);
        constexpr int NITEMS = 4 * (2 * IT_GU + 2 * IT_DN + IT_OUT + IT_KV) + 2 * (IT_INSB + IT_INS5 + IT_GLU);
#pragma unroll 1
        for (int it = gw; it < NITEMS; it += NGW) {
            int r = it;
            if (r < 8 * IT_GU) {
                const int which = r / (4 * IT_GU); r -= which * 4 * IT_GU; const int layer = r / IT_GU; r -= layer * IT_GU;
                const int nblk = 2 * FFN / 32, kb = r / nblk, nb = r % nblk, n0 = 32 * nb, bj = n0 / FFN, jj = n0 % FFN, drow0 = 256 * (jj / 128) + 128 * bj + (jj % 128);
                transpose_item(args.in[which ? I_F2GU : I_F1GU] + (size_t)layer * DM * 2 * FFN, DM, 2 * FFN, (which ? P_WGU2 : P_WGU1) + (size_t)layer * 2 * FFN * DM, 64 * kb, n0, drow0, scr, lane, args.in[which ? I_F2N : I_F1N] + (size_t)layer * DM);
                continue; }
            r -= 8 * IT_GU;
            if (r < 8 * IT_DN) {
                const int which = r / (4 * IT_DN); r -= which * 4 * IT_DN; const int layer = r / IT_DN; r -= layer * IT_DN;
                const int nblk = DM / 32, kb = r / nblk, nb = r % nblk;
                transpose_item(args.in[which ? I_F2DN : I_F1DN] + (size_t)layer * FFN * DM, FFN, DM, (which ? P_WDN2 : P_WDN1) + (size_t)layer * DM * FFN, 64 * kb, 32 * nb, 32 * nb, scr, lane);
                continue; }
            r -= 8 * IT_DN;
            if (r < 4 * IT_OUT) {
                const int layer = r / IT_OUT; r -= layer * IT_OUT; const int nblk = DM / 32, kb = r / nblk, nb = r % nblk;
                transpose_item(args.in[I_WOUT] + (size_t)layer * DM * DM, DM, DM, P_WOUT + (size_t)layer * DM * DM, 64 * kb, 32 * nb, 32 * nb, scr, lane);
                continue; }
            r -= 4 * IT_OUT;
            if (r < 4 * IT_KV) {
                const int layer = r / IT_KV; r -= layer * IT_KV; const int nblk = 1024 / 32, kb = r / nblk, nb = r % nblk;
                transpose_item(args.in[I_WKV] + (size_t)layer * DM * 1024, DM, 1024, P_WKV + (size_t)layer * 1024 * DM, 64 * kb, 32 * nb, 32 * nb, scr, lane);
                continue; }
            r -= 4 * IT_KV;
            if (r < 2 * IT_INSB) {
                const int j = r / IT_INSB; r -= j * IT_INSB; const int nblk = 5120 / 32, kb = r / nblk, nb = r % nblk, n0 = 32 * nb;
                const int drow0 = (n0 < 3072) ? n0 : (n0 < 4608 ? n0 + 512 : n0 - 1536);
                transpose_item(args.in[I_SBIN] + (size_t)j * DM * 5120, DM, 5120, P_WINSB + (size_t)j * 5120 * DM, 64 * kb, n0, drow0, scr, lane, args.in[I_MIXN] + (size_t)(2 * j) * DM);
                continue; }
            r -= 2 * IT_INSB;
            if (r < 2 * IT_INS5) {
                const int j = r / IT_INS5; r -= j * IT_INS5; const int nblk = DM / 32, kb = r / nblk, nb = r % nblk;
                transpose_item(args.in[I_S5IN] + (size_t)j * DM * DM, DM, DM, P_WINS5 + (size_t)j * DM * DM, 64 * kb, 32 * nb, 32 * nb, scr, lane, args.in[I_MIXN] + (size_t)(2 * j + 1) * DM);
                continue; }
            r -= 2 * IT_INS5;
            { const int j = r / IT_GLU; r -= j * IT_GLU; const int nblk = TOKW / 32, kb = r / nblk, nb = r % nblk;
              transpose_item(args.in[I_WGLU] + (size_t)j * TOKW * TOKW, TOKW, TOKW, P_WGLU + (size_t)j * TOKW * TOKW, 64 * kb, 32 * nb, 32 * nb, scr, lane); }
        }
#pragma unroll 1
        for (int m = gw; m < 4 * 512; m += NGW) { const int layer = m >> 9, rr = m & 511;
            rms_row_to_bf16(args.in[I_MEM] + (size_t)rr * DM, args.in[I_MEMN] + (size_t)layer * DM, P_MEMH + (size_t)m * DM, lane); }
#pragma unroll 1
        for (int idx = gw * 64 + lane; idx < 2 * S5G * S5N; idx += NGW * 64) {
            const int j = idx / (S5G * S5N), g = (idx / S5N) % S5G, n = idx % S5N;
            const double dt = d_exp((double)args.in[I_LOGDT][j * S5G + g]);
            const double lre = (double)args.in[I_ARE][(j * S5G + g) * S5N + n], lim = (double)args.in[I_AIM][(j * S5G + g) * S5N + n];
            const double ea = d_exp(lre * dt); double sn, cs; d_sincos(lim * dt, sn, cs);
            const double are = ea * cs, aim = ea * sn;
            const double nr = are - 1.0, ni = aim, den = lre * lre + lim * lim;
            const double cre = (nr * lre + ni * lim) / den, cim = (ni * lre - nr * lim) / den;
            const float* bre = args.in[I_BRE] + ((size_t)(j * S5G + g) * S5N + n) * S5C; const float* bim = args.in[I_BIM] + ((size_t)(j * S5G + g) * S5N + n) * S5C;
            bf16* bo = P_BBAR + ((size_t)(j * S5G + g) * 128 + 2 * n) * 16;
#pragma unroll 1
            for (int c = 0; c < S5C; ++c) { const double br = bre[c], bi = bim[c]; bo[c] = (bf16)f2bf((float)(cre * br - cim * bi)); bo[16 + c] = (bf16)f2bf((float)(cre * bi + cim * br)); }
            const float* cr = args.in[I_CRE] + (size_t)(j * S5G + g) * S5C * S5N; const float* ci = args.in[I_CIM] + (size_t)(j * S5G + g) * S5C * S5N;
            bf16* co = P_CCAT + (size_t)(j * S5G + g) * 16 * 128;
#pragma unroll 1
            for (int c = 0; c < S5C; ++c) { co[c * 128 + 2 * n] = (bf16)f2bf(cr[c * S5N + n]); co[c * 128 + 2 * n + 1] = (bf16)f2bf(-ci[c * S5N + n]); }
            double tr = are, ti = aim;
#pragma unroll 1
            for (int s = 0; s < S5T_LOG2; ++s) { const double t2r = tr * tr - ti * ti, t2i = 2.0 * tr * ti; tr = t2r; ti = t2i; }
            *(f32x4*)(P_ABAR + ((size_t)(j * S5G + g) * 64 + n) * 4) = (f32x4){(float)are, (float)aim, (float)tr, (float)ti};
        }
    }
    GRID_BAR();
    {
        PHASE_VARS
        pg8::KvSched S; S.A = (const char*)P_MEMH; S.B = (const char*)P_WKV; S.tstep = (size_t)256 * DM * 2; S.G = G; S.c = bx;
        pg8::EpiBf16 E{P_KVM, 1024, P_KVM, 1024, 3};
        pg8::gemm_phase<pg8::EpiBf16, pg8::KvSched, true, true>(lds, DM, S, E, ptid);
        const int nkv = (G > 64) ? 32 : 0;
        if (bx >= nkv) {
            const int gw2 = (bx - nkv) * 8 + wave, ngw2 = (G - nkv) * 8;
#pragma unroll 1
            for (int m = gw2; m < M; m += ngw2) {
                const GAS f32x4* xr = (const GAS f32x4*)(args.in[I_X] + (size_t)m * DM) + lane; GAS u32x2* o8 = (GAS u32x2*)(P_XN + (size_t)m * DM) + lane; float s = 0.f;
#pragma unroll
                for (int j = 0; j < 8; ++j) { const f32x4 v = xr[64 * j]; s += (v.x * v.x + v.y * v.y) + (v.z * v.z + v.w * v.w); u32x2 w; w.x = pk2(v.x, v.y); w.y = pk2(v.z, v.w); o8[64 * j] = w; }
                s = wave_sum(s); if (lane == 0) ((GAS u64*)P_RSS)[m] = (u64)(s * 1048576.0f + 0.5f);
            }
        }
    }
    GRID_BAR();
    {
        PHASE_VARS
#pragma unroll 1
        for (int rr = gw; rr < 4 * 512; rr += NGW) {
            const int layer = rr >> 9, b = (rr >> 8) & 1, m = rr & 255;
            const GAS bf16* kvrow = (const GAS bf16*)P_KVM + (size_t)rr * 1024;
            const int hm = lane >> 4, d0 = (lane & 15) * 8;
            const bf16x8 kv = *(const GAS bf16x8*)(kvrow + lane * 8); const bf16x8 vv = *(const GAS bf16x8*)(kvrow + 512 + lane * 8);
            float kf[8], ss = 0.f;
#pragma unroll
            for (int j = 0; j < 8; ++j) { kf[j] = bf2f((unsigned short)kv[j]); ss += kf[j] * kf[j]; }
            ss += __shfl_xor(ss, 1); ss += __shfl_xor(ss, 2); ss += __shfl_xor(ss, 4); ss += __shfl_xor(ss, 8);
            const float rk = 1.0f / sqrtf(ss * (1.0f / HD) + EPS);
            const GAS float* kg = (const GAS float*)args.in[I_XKN] + layer * HD + d0; const GAS float* qg = (const GAS float*)args.in[I_XQN] + layer * HD + d0;
            u32x4 w; unsigned wv[4];
#pragma unroll
            for (int j = 0; j < 4; ++j) wv[j] = pk2(kf[2 * j] * rk * kg[2 * j] * qg[2 * j], kf[2 * j + 1] * rk * kg[2 * j + 1] * qg[2 * j + 1]);
            w.x = wv[0]; w.y = wv[1]; w.z = wv[2]; w.w = wv[3];
            *(GAS u32x4*)((GAS bf16*)P_KN + ((size_t)((layer * 2 + b) * 4 + hm) * NMEM + m) * HD + d0) = w;
            GAS bf16* vt = (GAS bf16*)P_VTM + ((size_t)((layer * 2 + b) * 4 + hm) * HD + d0) * NMEM + m;
#pragma unroll
            for (int j = 0; j < 8; ++j) vt[(size_t)j * NMEM] = (bf16)vv[j];
        }
    }

#pragma unroll 1
    for (int layer = 0; layer < DEPTH; ++layer) {
        const int jj = layer >> 1; const bool is_sb = (layer & 1) == 0;
#pragma unroll 1
        for (int half = 0; half < 2; ++half) {
            const int cslot = 3 * layer + 2 * half;
            { PHASE_VARS
              pg8::DualSched S; S.t1.init(M, 2 * FFN); S.t2.init(0, 0); S.A1 = (const char*)P_XN; S.B1 = (const char*)((half ? P_WGU2 : P_WGU1) + (size_t)layer * 2 * FFN * DM); S.A2 = S.A1; S.B2 = S.B1;
              S.tstep = (size_t)256 * DM * 2; S.G = G; S.c = bx;
              pg8::EpiSwiGLU E{P_ACT, FFN, P_RSS + (size_t)cslot * M};
              pg8::gemm_phase<pg8::EpiSwiGLU, pg8::DualSched, true, true>(lds, DM, S, E, ptid); }
            GRID_BAR();
            { PHASE_VARS
              pg8::DualSched S; S.t1.init(M, DM); S.t2.init(0, 0); S.A1 = (const char*)P_ACT; S.B1 = (const char*)((half ? P_WDN2 : P_WDN1) + (size_t)layer * DM * FFN); S.A2 = S.A1; S.B2 = S.B1;
              S.tstep = (size_t)256 * FFN * 2; S.G = G; S.c = bx;
              const bool lastu = (layer == DEPTH - 1 && half == 1);
              pg8::EpiResid E{P_XN, DM, 0.5f, P_RSS + (size_t)(cslot + 1) * M, lastu ? out : nullptr};
              pg8::gemm_phase<pg8::EpiResid, pg8::DualSched, true, true>(lds, FFN, S, E, ptid); }
            GRID_BAR();
            if (half == 0) {
                { PHASE_VARS
                  { GAS float* rkp = (GAS float*)(ws + WS_RK); const GAS u64* rs = (const GAS u64*)(P_RSS + (size_t)(cslot + 1) * M);
#pragma unroll 1
                    for (int t = bx * 512 + ptid; t < M; t += G * 512) rkp[t] = __builtin_amdgcn_rsqf(rss2f(rs[t]) * (1.0f / DM) + EPS); }
                  pg8::DualSched S; S.tstep = (size_t)256 * DM * 2; S.G = G; S.c = bx;
                  pg8::EpiBf16 E{P_PROJ, is_sb ? PROJ_SB : PROJ_S5, P_VT, M, 0x7fffffff};
                  if (is_sb) { const bf16* W = P_WINSB + (size_t)jj * 5120 * DM; S.t1.init(M, PROJ_SB); S.t2.init(TOKW, M);
                      S.A1 = (const char*)P_XN; S.B1 = (const char*)W; S.A2 = (const char*)(W + (size_t)PROJ_SB * DM); S.B2 = (const char*)P_XN; }
                  else { S.t1.init(M, PROJ_S5); S.t2.init(0, 0); S.A1 = (const char*)P_XN; S.B1 = (const char*)(P_WINS5 + (size_t)jj * DM * DM); S.A2 = S.A1; S.B2 = S.B1; }
                  pg8::gemm_phase<pg8::EpiBf16, pg8::DualSched, true, true>(lds, DM, S, E, ptid); }
                GRID_BAR();
                if (is_sb) {
                    { PHASE_VARS
                      const bf16* KNl = P_KN + (size_t)layer * 2 * 4 * NMEM * HD; const bf16* VTMl = P_VTM + (size_t)layer * 2 * 4 * HD * NMEM;
                      constexpr int NSB = BATCH * SBH * (SEQ / 32);
#pragma unroll 1
                      for (int u = gw; u < NSB; u += NGW) { const int qt = u % (SEQ / 32), bh = u / (SEQ / 32); sb_attn_wave(P_PROJ, P_VT, P_TOK, (const float*)(ws + WS_RK), bh / SBH, bh % SBH, qt, lane, lds + wave * 8704); }
                      cross_attn_phase(P_PROJ, PROJ_SB, 2 * TOKW, KNl, VTMl, P_TOK, P_RSS + (size_t)(cslot + 1) * M, lds, vcu, G, ptid, wave, lane); }
                    GRID_BAR();
                } else {
                    constexpr int NS5 = BATCH * S5G * S5NC, NCR = BATCH * MEMHEADS * (SEQ / 32);
                    { PHASE_VARS
                      const bf16* KNl = P_KN + (size_t)layer * 2 * 4 * NMEM * HD; const bf16* VTMl = P_VTM + (size_t)layer * 2 * 4 * HD * NMEM;
                      const bf16* Bb = P_BBAR + (size_t)jj * S5G * 128 * 16; const bf16* Cc = P_CCAT + (size_t)jj * S5G * 16 * 128; const float* Ab = P_ABAR + (size_t)jj * S5G * 64 * 4;
                      const float* dsk = args.in[I_S5D] + (size_t)jj * TOKW;
                      LAS unsigned char* wl = lds + wave * S5_LDS_WAVE;
#pragma unroll 1
                      for (int u = gw; u < NS5; u += NGW) { const int c = u / (BATCH * S5G), bg = u % (BATCH * S5G); s5_pass0_wave(P_PROJ, Bb, Ab, P_EB, P_RSS + (size_t)(cslot + 1) * M, bg / S5G, bg % S5G, c, wl, lane); }
                      cross_attn_phase(P_PROJ, PROJ_S5, TOKW, KNl, VTMl, P_TOK, P_RSS + (size_t)(cslot + 1) * M, lds, vcu, G, ptid, wave, lane); }
                    GRID_BAR();
                    { PHASE_VARS
                      const bf16* Bb = P_BBAR + (size_t)jj * S5G * 128 * 16; const bf16* Cc = P_CCAT + (size_t)jj * S5G * 16 * 128; const float* Ab = P_ABAR + (size_t)jj * S5G * 64 * 4;
                      const float* dsk = args.in[I_S5D] + (size_t)jj * TOKW;
                      LAS unsigned char* wl = lds + wave * S5_LDS_WAVE;
#pragma unroll 1
                      for (int u = gw; u < NS5; u += NGW) { const int c = u / (BATCH * S5G), bg = u % (BATCH * S5G); s5_wave<1>(P_PROJ, Bb, Cc, Ab, dsk, P_EB, P_YB, P_RSS + (size_t)(cslot + 1) * M, bg / S5G, bg % S5G, c, wl, lane); } }
                    GRID_BAR();
                    { PHASE_VARS
                      pg8::DualSched S; S.t1.init(M, TOKW); S.t2.init(0, 0); S.A1 = (const char*)P_YB; S.B1 = (const char*)(P_WGLU + (size_t)jj * TOKW * TOKW); S.A2 = S.A1; S.B2 = S.B1;
                      S.tstep = (size_t)256 * TOKW * 2; S.G = G; S.c = bx;
                      pg8::EpiGLU E{P_YB, TOKW, P_TOK, DM};
                      pg8::gemm_phase<pg8::EpiGLU, pg8::DualSched, true, true>(lds, TOKW, S, E, ptid); }
                    GRID_BAR();
                }
                { PHASE_VARS
                  pg8::DualSched S; S.t1.init(M, DM); S.t2.init(0, 0); S.A1 = (const char*)P_TOK; S.B1 = (const char*)(P_WOUT + (size_t)layer * DM * DM); S.A2 = S.A1; S.B2 = S.B1;
                  S.tstep = (size_t)256 * DM * 2; S.G = G; S.c = bx;
                  pg8::EpiResid E{P_XN, DM, 1.0f, P_RSS + (size_t)(cslot + 2) * M, nullptr};
                  pg8::gemm_phase<pg8::EpiResid, pg8::DualSched, true, true>(lds, DM, S, E, ptid); }
                GRID_BAR();
            }
        }
    }
}

extern "C" void kernel_launch(void* const* d_in, const int* in_sizes, int n_in, void* d_out, int out_size, void* d_ws, size_t ws_size, hipStream_t stream) {
    static int grid = 0;
    if (grid == 0) {
        if (n_in != 25 || in_sizes[0] != M * DM || out_size != M * DM || ws_size < WS_END) {
            fprintf(stderr, "kernel_launch: shape/workspace mismatch: n_in %d in0 %d out %d ws %zu (need %zu)\n", n_in, n_in > 0 ? in_sizes[0] : -1, out_size, ws_size, (size_t)WS_END); grid = -1; return; }
        int dev = 0, cus = 0, per_cu = 0;
        if (hipGetDevice(&dev) != hipSuccess || hipDeviceGetAttribute(&cus, hipDeviceAttributeMultiprocessorCount, dev) != hipSuccess) { fprintf(stderr, "kernel_launch: device query failed\n"); grid = -1; return; }
        if (hipFuncSetAttribute((const void*)fwd, hipFuncAttributeMaxDynamicSharedMemorySize, LDS_BYTES) != hipSuccess) { fprintf(stderr, "kernel_launch: hipFuncSetAttribute failed\n"); grid = -1; return; }
        if (hipOccupancyMaxActiveBlocksPerMultiprocessor(&per_cu, (const void*)fwd, 512, LDS_BYTES) != hipSuccess || per_cu < 1)
            fprintf(stderr, "kernel_launch: note: occupancy query reports %d workgroups per CU\n", per_cu);
        (void)hipGetLastError();
        grid = cus;
    }
    if (grid < 0) return;
    if (hipMemsetAsync((char*)d_ws + WS_CTL, 0, CTL_ZERO_BYTES, stream) != hipSuccess) { fprintf(stderr, "kernel_launch: memset failed\n"); return; }
    Args a{};
    for (int i = 0; i < 25; ++i) a.in[i] = (const float*)d_in[i];
    a.out = (float*)d_out; a.ws = (unsigned char*)d_ws;
    hipLaunchKernelGGL(fwd, dim3(grid), dim3(512), LDS_BYTES, stream, a);
    const hipError_t le = hipPeekAtLastError();
    if (le != hipSuccess) fprintf(stderr, "kernel_launch: launch failed: %s\n", hipGetErrorName(le));
}
```

```cpp
#include <hip/hip_runtime.h>
#include <cstdio>
#include <cstdint>

#define LAS __attribute__((address_space(3)))
#define GAS __attribute__((address_space(1)))
typedef unsigned short bf16;
typedef short bf16x8 __attribute__((ext_vector_type(8)));
typedef short bf16x4 __attribute__((ext_vector_type(4)));
typedef float f32x4 __attribute__((ext_vector_type(4)));
typedef float f32x2 __attribute__((ext_vector_type(2)));
typedef unsigned u32x4 __attribute__((ext_vector_type(4)));
typedef unsigned u32x2 __attribute__((ext_vector_type(2)));
typedef unsigned long long u64;
__device__ __forceinline__ float rss2f(u64 v) { return __builtin_fmaf((float)(unsigned)(v >> 32), 4096.0f, (float)(unsigned)v * (1.0f / 1048576.0f)); }

constexpr int BATCH = 2, SEQ = 8192, DM = 2048, DEPTH = 4, M = BATCH * SEQ;
constexpr int NMEM = 256, HD = 128, MEMW = 512, MEMHEADS = 4, TOKW = 1536, SBH = 12;
constexpr int FFN = 5632, S5G = 96, S5C = 16, S5N = 64;
constexpr int PROJ_SB = 3584;
constexpr int PROJ_S5 = 2048;
constexpr int S5T = 256, S5NC = SEQ / S5T, S5T_LOG2 = 8;
constexpr float EPS = 1e-6f;

constexpr size_t MiB = 1u << 20;
constexpr size_t WS_CTL = 0, CTL_ZERO_BYTES = 3 * MiB;
constexpr size_t WS_RSS = 1 * MiB;
constexpr size_t SZ_GU = (size_t)2 * FFN * DM * 2, SZ_DN = (size_t)DM * FFN * 2, SZ_OUT = (size_t)DM * DM * 2, SZ_KV = (size_t)1024 * DM * 2;
constexpr size_t SZ_INSB = (size_t)5120 * DM * 2, SZ_INS5 = (size_t)DM * DM * 2, SZ_GLU = (size_t)TOKW * TOKW * 2;
constexpr size_t WS_WGU1 = 3 * MiB;
constexpr size_t WS_WDN1 = WS_WGU1 + 4 * SZ_GU;
constexpr size_t WS_WGU2 = WS_WDN1 + 4 * SZ_DN;
constexpr size_t WS_WDN2 = WS_WGU2 + 4 * SZ_GU;
constexpr size_t WS_WOUT = WS_WDN2 + 4 * SZ_DN;
constexpr size_t WS_WKV = WS_WOUT + 4 * SZ_OUT;
constexpr size_t WS_WINSB = WS_WKV + 4 * SZ_KV;
constexpr size_t WS_WINS5 = WS_WINSB + 2 * SZ_INSB;
constexpr size_t WS_WGLU = WS_WINS5 + 2 * SZ_INS5;
constexpr size_t WS_XN = WS_WGLU + 2 * SZ_GLU;
constexpr size_t WS_ACT = WS_XN + (size_t)M * DM * 2;
constexpr size_t WS_PROJ = WS_ACT + (size_t)M * FFN * 2;
constexpr size_t WS_VT = WS_PROJ + (size_t)M * PROJ_SB * 2;
constexpr size_t WS_TOK = WS_VT + (size_t)TOKW * M * 2;
constexpr size_t WS_MEMH = WS_TOK + (size_t)M * DM * 2;
constexpr size_t WS_KVM = WS_MEMH + (size_t)4 * 512 * DM * 2;
constexpr size_t WS_KN = WS_KVM + (size_t)4 * 512 * 1024 * 2;
constexpr size_t WS_VTM = WS_KN + (size_t)4 * 2 * 4 * 256 * 128 * 2;
constexpr size_t WS_BBAR = WS_VTM + (size_t)4 * 2 * 4 * 256 * 128 * 2;
constexpr size_t WS_CCAT = WS_BBAR + (size_t)2 * 96 * 128 * 16 * 2;
constexpr size_t WS_ABAR = WS_CCAT + (size_t)2 * 96 * 16 * 128 * 2;
constexpr size_t WS_E = WS_ABAR + (size_t)2 * 96 * 64 * 16;
constexpr size_t WS_END = WS_E + (size_t)2 * 96 * S5NC * 64 * 8;
constexpr int CW_BAR = 4096;

constexpr int RING_BYTES = 131072;
constexpr int LDS_BYTES = 163840;
constexpr int LDSCTL_OFF = LDS_BYTES - 512, MISC_OFF = LDSCTL_OFF + 320;
constexpr int XK_ROWB = 256 + 16, XV_ROWB = 512 + 16, XV_OFF = 256 * XK_ROWB, X_STAGE_BYTES = XV_OFF + 128 * XV_ROWB;
static_assert(X_STAGE_BYTES <= LDSCTL_OFF, "cross-attention K/V image fits under the LDS control words");

namespace pg8 {
constexpr int BM = 256, BK = 64, HALF = 128, HTB = HALF * BK * 2, STAGE_BYTES = 8 * HTB, NXCD = 8, WGM = 8;
__host__ __device__ __forceinline__ int lds_byte(int r, int c) { const int st = (r >> 4) * 2 + (c >> 5), rr = r & 15, cc = c & 31, ob = rr * 64 + cc * 2; return st * 1024 + (ob ^ (((ob >> 9) & 1) << 5)); }
__host__ __device__ __forceinline__ void stage_rc(int b, int& R, int& C) { const int st = b / 1024, sb = b % 1024, swz = sb ^ (((sb >> 9) & 1) << 5); R = (st >> 1) * 16 + swz / 64; C = (st & 1) * 32 + (swz % 64) / 2; }
__host__ __device__ __forceinline__ int perm32(int rho) { const int n = rho >> 4, i = rho & 15; return 8 * (i >> 2) + 4 * n + (i & 3); }

struct Unit { int pm, pn, sel; };
struct TileOrder {
    int nM, nN, nwg;
    __device__ __forceinline__ void init(int Mr, int Nc) { nM = Mr / BM; nN = Nc / BM; nwg = nM * nN; }
    __device__ __forceinline__ void map(int L, int& pm, int& pn) const {
        int wgid = L; { const int q = nwg / NXCD, r = nwg % NXCD, xcd = wgid % NXCD, off = wgid / NXCD; wgid = (xcd < r ? xcd * (q + 1) : r * (q + 1) + (xcd - r) * q) + off; }
        const int nig = WGM * nN, gid = wgid / nig, fm = gid * WGM, gsz = (nM - fm) < WGM ? (nM - fm) : WGM;
        pm = fm + ((wgid % nig) % gsz); pn = (wgid % nig) / gsz;
    }
};
struct DualSched {
    TileOrder t1, t2; const char *A1, *B1, *A2, *B2; size_t tstep; int G, c;
    __device__ __forceinline__ bool next(int i, Unit& u) const {
        const int L = i * G + c;
        if (L < t1.nwg) { t1.map(L, u.pm, u.pn); u.sel = 0; return true; }
        if (L < t1.nwg + t2.nwg) { t2.map(L - t1.nwg, u.pm, u.pn); u.sel = 1; return true; }
        return false;
    }
    __device__ __forceinline__ const char* a_ptr(const Unit& u) const { return (u.sel ? A2 : A1) + (size_t)u.pm * tstep; }
    __device__ __forceinline__ const char* b_ptr(const Unit& u) const { return (u.sel ? B2 : B1) + (size_t)u.pn * tstep; }
};
struct KvSched {
    const char *A, *B; size_t tstep; int G, c;
    __device__ __forceinline__ bool next(int i, Unit& u) const { const int L = i * G + c; if (L >= 32) return false; const int layer = L >> 3; u.pm = 2 * layer + (L & 1); u.pn = 4 * layer + ((L >> 1) & 3); u.sel = 0; return true; }
    __device__ __forceinline__ const char* a_ptr(const Unit& u) const { return A + (size_t)u.pm * tstep; }
    __device__ __forceinline__ const char* b_ptr(const Unit& u) const { return B + (size_t)u.pn * tstep; }
};

__device__ __forceinline__ unsigned cvt_pk_bf16(float lo, float hi) { unsigned r; asm volatile("v_cvt_pk_bf16_f32 %0, %1, %2" : "=v"(r) : "v"(lo), "v"(hi)); return r; }
__device__ __forceinline__ float fexp(float x) { return __builtin_amdgcn_exp2f(x * 1.4426950408889634f); }
__device__ __forceinline__ float flog(float x) { return __builtin_amdgcn_logf(x) * 0.6931471805599453f; }
__device__ __forceinline__ float fsigmoid(float x) { return __builtin_amdgcn_rcpf(1.0f + fexp(-x)); }

struct EpiSwiGLU {
    static constexpr bool PERM = true;
    struct Pre { u64 rs[8]; };
    bf16* O; int ldc; const u64* rss;
    __device__ __forceinline__ void prefetch(Pre& p, const Unit& u, int wr, int fr) const {
        const GAS u64* r = (const GAS u64*)rss + u.pm * BM + wr * 64 + fr;
#pragma unroll
        for (int ai = 0; ai < 2; ++ai)
#pragma unroll
            for (int m = 0; m < 4; ++m) p.rs[ai * 4 + m] = r[ai * HALF + m * 16];
    }
    __device__ __forceinline__ void operator()(const f32x4 (&acc)[2][2][4][2], const Unit& u, const Pre& p, int wr, int wc, int fr, int fq) const {
        const int row0 = u.pm * BM + wr * 64 + fr, col0 = u.pn * HALF + wc * 32 + 8 * fq;
#pragma unroll
        for (int ai = 0; ai < 2; ++ai)
#pragma unroll
            for (int m = 0; m < 4; ++m) {
                GAS bf16* rowp = (GAS bf16*)O + (size_t)(row0 + ai * HALF + m * 16) * ldc + col0;
                const float rr = __builtin_amdgcn_rsqf(rss2f(p.rs[ai * 4 + m]) * (1.0f / DM) + EPS);
                const float nl = -1.4426950408889634f * rr, rr2 = rr * rr;
                f32x2 t2[4], gu[4], o2[4];
#pragma unroll
                for (int q = 0; q < 4; ++q) { const f32x2 ag = (f32x2){acc[ai][0][m][q >> 1][2 * (q & 1)], acc[ai][0][m][q >> 1][2 * (q & 1) + 1]}, au = (f32x2){acc[ai][1][m][q >> 1][2 * (q & 1)], acc[ai][1][m][q >> 1][2 * (q & 1) + 1]};
                    t2[q] = ag * nl; gu[q] = (ag * au) * rr2; }
#pragma unroll
                for (int q = 0; q < 4; ++q) { t2[q].x = __builtin_amdgcn_exp2f(t2[q].x); t2[q].y = __builtin_amdgcn_exp2f(t2[q].y); }
#pragma unroll
                for (int q = 0; q < 4; ++q) { t2[q] = t2[q] + 1.0f; }
#pragma unroll
                for (int q = 0; q < 4; ++q) { t2[q].x = __builtin_amdgcn_rcpf(t2[q].x); t2[q].y = __builtin_amdgcn_rcpf(t2[q].y); }
#pragma unroll
                for (int q = 0; q < 4; ++q) o2[q] = gu[q] * t2[q];
                u32x4 w; w.x = cvt_pk_bf16(o2[0].x, o2[0].y); w.y = cvt_pk_bf16(o2[1].x, o2[1].y); w.z = cvt_pk_bf16(o2[2].x, o2[2].y); w.w = cvt_pk_bf16(o2[3].x, o2[3].y);
                *(GAS u32x4*)rowp = w;
            }
    }
};
struct EpiResid {
    static constexpr bool PERM = true;
    struct Pre {};
    bf16* xb; int ldc; float scale; u64* rss; float* outf;
    __device__ __forceinline__ void prefetch(Pre&, const Unit&, int, int) const {}
    __device__ __forceinline__ void operator()(const f32x4 (&acc)[2][2][4][2], const Unit& u, const Pre&, int wr, int wc, int fr, int fq) const {
        const int row0 = u.pm * BM + wr * 64 + fr, col0 = u.pn * BM + wc * 32 + 8 * fq;
#pragma unroll
        for (int ai = 0; ai < 2; ++ai) {
            u32x4 bs[4][2];
#pragma unroll
            for (int m = 0; m < 4; ++m)
#pragma unroll
                for (int bj = 0; bj < 2; ++bj) bs[m][bj] = *(const GAS u32x4*)((const GAS bf16*)xb + (size_t)(row0 + ai * HALF + m * 16) * ldc + col0 + bj * HALF);
#pragma unroll
            for (int m = 0; m < 4; ++m) { const size_t off = (size_t)(row0 + ai * HALF + m * 16) * ldc + col0; float s = 0.f;
#pragma unroll
                for (int bj = 0; bj < 2; ++bj) { float v[8];
#pragma unroll
                    for (int j = 0; j < 4; ++j) { const unsigned w = bs[m][bj][j]; const float lo = __uint_as_float(w << 16), hi = __uint_as_float(w & 0xffff0000u);
                        const float a0 = (j < 2) ? acc[ai][bj][m][0][2 * j] : acc[ai][bj][m][1][2 * j - 4], a1 = (j < 2) ? acc[ai][bj][m][0][2 * j + 1] : acc[ai][bj][m][1][2 * j - 3];
                        v[2 * j] = lo + a0 * scale; v[2 * j + 1] = hi + a1 * scale; }
                    if (outf) { *(GAS f32x4*)((GAS float*)outf + off + bj * HALF) = (f32x4){v[0], v[1], v[2], v[3]}; *(GAS f32x4*)((GAS float*)outf + off + bj * HALF + 4) = (f32x4){v[4], v[5], v[6], v[7]}; }
                    else { u32x4 w; w.x = cvt_pk_bf16(v[0], v[1]); w.y = cvt_pk_bf16(v[2], v[3]); w.z = cvt_pk_bf16(v[4], v[5]); w.w = cvt_pk_bf16(v[6], v[7]);
                        *(GAS u32x4*)((GAS bf16*)xb + off + bj * HALF) = w;
                        s += ((v[0] * v[0] + v[1] * v[1]) + (v[2] * v[2] + v[3] * v[3])) + ((v[4] * v[4] + v[5] * v[5]) + (v[6] * v[6] + v[7] * v[7])); } }
                if (!outf) { s += __shfl_xor(s, 16); s += __shfl_xor(s, 32);
                    if (fq == 0) (void)__hip_atomic_fetch_add((GAS u64*)rss + row0 + ai * HALF + m * 16, (u64)(s * 1048576.0f + 0.5f), __ATOMIC_RELAXED, __HIP_MEMORY_SCOPE_AGENT); } }
            asm volatile("" ::: "memory");
        }
    }
};
struct EpiBf16 {
    static constexpr bool PERM = true;
    struct Pre {};
    bf16* O0; int ldc0; bf16* O1; int ldc1; int pn_mask;
    __device__ __forceinline__ void prefetch(Pre&, const Unit&, int, int) const {}
    __device__ __forceinline__ void operator()(const f32x4 (&acc)[2][2][4][2], const Unit& u, const Pre&, int wr, int wc, int fr, int fq) const {
        bf16* O = u.sel ? O1 : O0; const int ldc = u.sel ? ldc1 : ldc0;
        const int row0 = u.pm * BM + wr * 64 + fr, col0 = (u.pn & pn_mask) * BM + wc * 32 + 8 * fq;
#pragma unroll
        for (int ai = 0; ai < 2; ++ai)
#pragma unroll
            for (int m = 0; m < 4; ++m) {
                GAS bf16* rowp = (GAS bf16*)O + (size_t)(row0 + ai * HALF + m * 16) * ldc + col0;
#pragma unroll
                for (int bj = 0; bj < 2; ++bj) { const f32x4 v0 = acc[ai][bj][m][0], v1 = acc[ai][bj][m][1];
                    u32x4 w; w.x = cvt_pk_bf16(v0[0], v0[1]); w.y = cvt_pk_bf16(v0[2], v0[3]); w.z = cvt_pk_bf16(v1[0], v1[1]); w.w = cvt_pk_bf16(v1[2], v1[3]);
                    *(GAS u32x4*)(rowp + bj * HALF) = w; }
            }
    }
};
struct EpiGLU {
    static constexpr bool PERM = true;
    struct Pre {};
    const bf16* Y; int ldy; bf16* O; int ldc;
    __device__ __forceinline__ void prefetch(Pre&, const Unit&, int, int) const {}
    __device__ __forceinline__ void operator()(const f32x4 (&acc)[2][2][4][2], const Unit& u, const Pre&, int wr, int wc, int fr, int fq) const {
        const int row0 = u.pm * BM + wr * 64 + fr, col0 = u.pn * BM + wc * 32 + 8 * fq;
#pragma unroll
        for (int ai = 0; ai < 2; ++ai)
#pragma unroll
            for (int m = 0; m < 4; ++m) {
                const size_t r = (size_t)(row0 + ai * HALF + m * 16);
#pragma unroll
                for (int bj = 0; bj < 2; ++bj) {
                    const u32x4 yv = *(const GAS u32x4*)((const GAS bf16*)Y + r * ldy + col0 + bj * HALF);
                    const f32x4 v0 = acc[ai][bj][m][0], v1 = acc[ai][bj][m][1];
                    f32x2 t2[4], o2[4];
#pragma unroll
                    for (int j = 0; j < 4; ++j) { const f32x2 aa = (j < 2) ? (f32x2){v0[2 * j], v0[2 * j + 1]} : (f32x2){v1[2 * j - 4], v1[2 * j - 3]}; t2[j] = aa * -1.4426950408889634f; }
#pragma unroll
                    for (int j = 0; j < 4; ++j) { t2[j].x = __builtin_amdgcn_exp2f(t2[j].x); t2[j].y = __builtin_amdgcn_exp2f(t2[j].y); }
#pragma unroll
                    for (int j = 0; j < 4; ++j) t2[j] = t2[j] + 1.0f;
#pragma unroll
                    for (int j = 0; j < 4; ++j) { t2[j].x = __builtin_amdgcn_rcpf(t2[j].x); t2[j].y = __builtin_amdgcn_rcpf(t2[j].y); }
#pragma unroll
                    for (int j = 0; j < 4; ++j) { const unsigned yw = yv[j]; o2[j] = (f32x2){__uint_as_float(yw << 16), __uint_as_float(yw & 0xffff0000u)} * t2[j]; }
                    u32x4 w; w.x = cvt_pk_bf16(o2[0].x, o2[0].y); w.y = cvt_pk_bf16(o2[1].x, o2[1].y); w.z = cvt_pk_bf16(o2[2].x, o2[2].y); w.w = cvt_pk_bf16(o2[3].x, o2[3].y);
                    *(GAS u32x4*)((GAS bf16*)O + r * ldc + col0 + bj * HALF) = w;
                }
            }
    }
};

template <class Epi, class Sched, bool ALIGN_EPI, bool SP2>
__device__ __forceinline__ void gemm_phase(LAS unsigned char* lds, const int K, const Sched& S, const Epi& E, const int tid) {
    const int wid = __builtin_amdgcn_readfirstlane(tid >> 6), lane = tid & 63, wr = wid >> 2, wc = wid & 3, fr = lane & 15, fq = lane >> 4;
    const int nt = K / BK;
    unsigned voffA[2], voffB[2];
#pragma unroll
    for (int i = 0; i < 2; ++i) { int R, C; stage_rc(tid * 16 + i * 8192, R, C); const int Rb = Epi::PERM ? ((R & ~31) + perm32(R & 31)) : R;
        voffA[i] = (unsigned)(R * K + C) * 2u; voffB[i] = (unsigned)(Rb * K + C) * 2u; }
    const size_t kstep = (size_t)(BK * 2);
    const size_t hstep = (size_t)HALF * K * 2;
    const unsigned ldsw = (unsigned)wid * 1024u;
    const int aoff = lds_byte(wr * 64 + fr, fq * 8), boff = lds_byte(wc * 32 + fr, fq * 8);
#define PG8_SA(b, h) (((b) * 2 + (h)) * HTB)
#define PG8_SB(b, h) ((4 + (b) * 2 + (h)) * HTB)
#define PG8_STAGE(bufoff, gbase, voff) do { _Pragma("unroll") for (int _i = 0; _i < 2; ++_i) \
        __builtin_amdgcn_global_load_lds((const unsigned*)((const char*)(gbase) + (voff)[_i]), (LAS unsigned*)(lds + (bufoff) + ldsw + _i * 8192), 16, 0, 0); } while (0)
#define PG8_LDA(dst, b, h) do { _Pragma("unroll") for (int m = 0; m < 4; ++m) _Pragma("unroll") for (int k = 0; k < 2; ++k) dst[m][k] = *(const LAS bf16x8*)(lds + PG8_SA(b, h) + aoff + m * 2048 + k * 1024); } while (0)
#define PG8_LDB(dst, b, h) do { _Pragma("unroll") for (int n = 0; n < 2; ++n) _Pragma("unroll") for (int k = 0; k < 2; ++k) dst[n][k] = *(const LAS bf16x8*)(lds + PG8_SB(b, h) + boff + n * 2048 + k * 1024); } while (0)
#define PG8_MMA(ai, bj, At, Bt) do { __builtin_amdgcn_s_setprio(1); _Pragma("unroll") for (int m = 0; m < 4; ++m) _Pragma("unroll") for (int n = 0; n < 2; ++n) _Pragma("unroll") for (int k = 0; k < 2; ++k) \
        acc[ai][bj][m][n] = __builtin_amdgcn_mfma_f32_16x16x32_bf16(Bt[n][k], At[m][k], acc[ai][bj][m][n], 0, 0, 0); __builtin_amdgcn_s_setprio(0); } while (0)
#define PG8_WAIT_V(n) asm volatile("s_waitcnt vmcnt(" #n ")" ::: "memory")
#define PG8_WAIT_L(n) asm volatile("s_waitcnt lgkmcnt(" #n ")" ::: "memory")
#define PG8_BAR __builtin_amdgcn_s_barrier()
#define PG8_SCHED __builtin_amdgcn_sched_barrier(0)
    Unit cur, nxt; int ui = 0;
    if (!S.next(0, cur)) return;
    f32x4 acc[2][2][4][2];
#pragma unroll
    for (int a = 0; a < 2; ++a)
#pragma unroll
        for (int b = 0; b < 2; ++b)
#pragma unroll
            for (int m = 0; m < 4; ++m)
#pragma unroll
                for (int n = 0; n < 2; ++n) acc[a][b][m][n] = (f32x4){0.f, 0.f, 0.f, 0.f};
    bf16x8 At[4][2], B0[2][2], B1[2][2];
    const char* cA = S.a_ptr(cur); const char* cB = S.b_ptr(cur);
    typename Epi::Pre pre; E.prefetch(pre, cur, wr, fr);
    if constexpr (SP2) {
        PG8_STAGE(PG8_SB(0, 0), cB, voffB); PG8_STAGE(PG8_SB(0, 1), cB + hstep, voffB); PG8_STAGE(PG8_SA(0, 0), cA, voffA); PG8_STAGE(PG8_SA(0, 1), cA + hstep, voffA);
        if (wr == 1) PG8_BAR;
        PG8_WAIT_V(2); PG8_BAR;
        PG8_STAGE(PG8_SB(1, 0), cB + kstep, voffB); PG8_STAGE(PG8_SA(1, 0), cA + kstep, voffA); PG8_STAGE(PG8_SB(1, 1), cB + hstep + kstep, voffB);
        PG8_WAIT_V(6); PG8_BAR;
    } else {
        PG8_STAGE(PG8_SB(0, 0), cB, voffB); PG8_STAGE(PG8_SA(0, 0), cA, voffA); PG8_STAGE(PG8_SB(0, 1), cB + hstep, voffB); PG8_STAGE(PG8_SA(0, 1), cA + hstep, voffA);
        if (wr == 1) PG8_BAR;
        PG8_WAIT_V(4); PG8_BAR;
        PG8_STAGE(PG8_SB(1, 0), cB + kstep, voffB); PG8_STAGE(PG8_SA(1, 0), cA + kstep, voffA); PG8_STAGE(PG8_SB(1, 1), cB + hstep + kstep, voffB);
        PG8_WAIT_V(6); PG8_BAR;
    }
    for (;;) {
        const bool has_next = S.next(ui + 1, nxt);
        const char* nA = has_next ? S.a_ptr(nxt) : cA; const char* nB = has_next ? S.b_ptr(nxt) : cB;
        for (int t = 0; t < nt; t += 2) {
            const bool last = (t == nt - 2);
            const char* a1 = cA + (size_t)(t + 1) * kstep;
            const char* a2 = last ? nA : cA + (size_t)(t + 2) * kstep; const char* b2 = last ? nB : cB + (size_t)(t + 2) * kstep;
            const char* a3 = a2 + kstep; const char* b3 = b2 + kstep;
            if constexpr (SP2) {
            PG8_LDB(B0, 0, 0); PG8_LDB(B1, 0, 1); PG8_SCHED; PG8_LDA(At, 0, 0); PG8_STAGE(PG8_SA(1, 1), a1 + hstep, voffA);
            PG8_WAIT_V(8); PG8_WAIT_L(0); PG8_BAR; PG8_MMA(0, 0, At, B0); PG8_MMA(0, 1, At, B1); PG8_BAR; PG8_SCHED;
            PG8_LDA(At, 0, 1); PG8_STAGE(PG8_SB(0, 0), b2, voffB); PG8_STAGE(PG8_SB(0, 1), b2 + hstep, voffB); PG8_STAGE(PG8_SA(0, 0), a2, voffA);
            PG8_WAIT_V(8); PG8_WAIT_L(0); PG8_BAR; PG8_MMA(1, 0, At, B0); PG8_MMA(1, 1, At, B1); PG8_BAR; PG8_SCHED;
            PG8_LDB(B0, 1, 0); PG8_LDB(B1, 1, 1); PG8_SCHED; PG8_LDA(At, 1, 0); PG8_STAGE(PG8_SA(0, 1), a2 + hstep, voffA);
            PG8_WAIT_V(8); PG8_WAIT_L(0); PG8_BAR; PG8_MMA(0, 0, At, B0); PG8_MMA(0, 1, At, B1); PG8_BAR; PG8_SCHED;
            PG8_LDA(At, 1, 1); PG8_STAGE(PG8_SB(1, 0), b3, voffB); PG8_STAGE(PG8_SB(1, 1), b3 + hstep, voffB); PG8_STAGE(PG8_SA(1, 0), a3, voffA);
            PG8_WAIT_V(8); PG8_WAIT_L(0); PG8_BAR; PG8_MMA(1, 0, At, B0); PG8_MMA(1, 1, At, B1); PG8_BAR; PG8_SCHED;
            } else {
            PG8_LDB(B0, 0, 0); PG8_SCHED; PG8_LDA(At, 0, 0); PG8_STAGE(PG8_SA(1, 1), a1 + hstep, voffA);
            PG8_WAIT_L(8); PG8_BAR; PG8_WAIT_L(0); PG8_MMA(0, 0, At, B0); PG8_BAR; PG8_SCHED;
            PG8_LDB(B1, 0, 1); PG8_STAGE(PG8_SB(0, 0), b2, voffB);
            PG8_BAR; PG8_WAIT_L(0); PG8_MMA(0, 1, At, B1); PG8_BAR;
            PG8_LDA(At, 0, 1); PG8_STAGE(PG8_SA(0, 0), a2, voffA);
            PG8_BAR; PG8_WAIT_L(0); PG8_MMA(1, 0, At, B0); PG8_BAR; PG8_SCHED;
            PG8_STAGE(PG8_SB(0, 1), b2 + hstep, voffB);
            PG8_WAIT_V(6); PG8_BAR; PG8_MMA(1, 1, At, B1); PG8_BAR;
            PG8_LDB(B0, 1, 0); PG8_SCHED; PG8_LDA(At, 1, 0); PG8_STAGE(PG8_SA(0, 1), a2 + hstep, voffA);
            PG8_WAIT_L(8); PG8_BAR; PG8_WAIT_L(0); PG8_MMA(0, 0, At, B0); PG8_BAR; PG8_SCHED;
            PG8_LDB(B1, 1, 1); PG8_STAGE(PG8_SB(1, 0), b3, voffB);
            PG8_BAR; PG8_WAIT_L(0); PG8_MMA(0, 1, At, B1); PG8_BAR;
            PG8_LDA(At, 1, 1); PG8_STAGE(PG8_SA(1, 0), a3, voffA);
            PG8_BAR; PG8_WAIT_L(0); PG8_MMA(1, 0, At, B0); PG8_BAR; PG8_SCHED;
            PG8_STAGE(PG8_SB(1, 1), b3 + hstep, voffB);
            PG8_WAIT_V(6); PG8_BAR; PG8_MMA(1, 1, At, B1); PG8_BAR;
            }
        }
        if constexpr (ALIGN_EPI) { if (wr == 0) PG8_BAR; }
        E(acc, cur, pre, wr, wc, fr, fq);
        if (!has_next) break;
#pragma unroll
        for (int a = 0; a < 2; ++a)
#pragma unroll
            for (int b = 0; b < 2; ++b)
#pragma unroll
                for (int m = 0; m < 4; ++m)
#pragma unroll
                    for (int n = 0; n < 2; ++n) acc[a][b][m][n] = (f32x4){0.f, 0.f, 0.f, 0.f};
        cur = nxt; cA = nA; cB = nB; ++ui;
        E.prefetch(pre, cur, wr, fr);
        if constexpr (ALIGN_EPI) { if (wr == 1) PG8_BAR; }
    }
    PG8_WAIT_V(0);
    if constexpr (!ALIGN_EPI) { if (wr == 0) PG8_BAR; }
    PG8_BAR;
#undef PG8_SA
#undef PG8_SB
#undef PG8_STAGE
#undef PG8_LDA
#undef PG8_LDB
#undef PG8_MMA
#undef PG8_WAIT_V
#undef PG8_WAIT_L
#undef PG8_BAR
#undef PG8_SCHED
}
}

typedef GAS unsigned gu32;
#define RLX_AGENT __ATOMIC_RELAXED, __HIP_MEMORY_SCOPE_AGENT
#define LDS_WAIT() asm volatile("s_waitcnt lgkmcnt(0)" ::: "memory")
#define VM_WAIT() asm volatile("s_waitcnt vmcnt(0)" ::: "memory")
__device__ __forceinline__ unsigned f2bf(float f) { unsigned u = __builtin_bit_cast(unsigned, f); return (u + 0x7fffu + ((u >> 16) & 1u)) >> 16; }
__device__ __forceinline__ unsigned pk2(float lo, float hi) { return pg8::cvt_pk_bf16(lo, hi); }
__device__ __forceinline__ float bf2f(unsigned short b) { return __uint_as_float(((unsigned)b) << 16); }
__device__ __forceinline__ f32x4 mfma16(bf16x8 a, bf16x8 b, f32x4 c) { return __builtin_amdgcn_mfma_f32_16x16x32_bf16(a, b, c, 0, 0, 0); }
using pg8::cvt_pk_bf16; using pg8::fexp; using pg8::flog; using pg8::fsigmoid;

#define XB_TMO      128
#define XB_XCNT(j)  (256  + 64 * (j))
#define XB_XSUB(j)  (1280 + 64 * (j))
#define XB_XGEN(j)  (2304 + 64 * (j))
#define XB_TOP      3328
#define XB_TOPGEN   3392
#define XCD_BAR_WORDS 3456
#define XB_SPIN_CAP (1u << 21)
__device__ __forceinline__ unsigned xb_ld(unsigned* p)              { return __hip_atomic_load(p, __ATOMIC_RELAXED, __HIP_MEMORY_SCOPE_AGENT); }
__device__ __forceinline__ unsigned xb_add(unsigned* p, unsigned v) { return __hip_atomic_fetch_add(p, v, __ATOMIC_RELAXED, __HIP_MEMORY_SCOPE_AGENT); }
__device__ __forceinline__ unsigned xb_xcc_id() { return (unsigned)__builtin_amdgcn_s_getreg((3 << 11) | 20) & 0xFu; }
#define XB_SPIN(cond, bar) do { unsigned _sp = 0; while (cond) { __builtin_amdgcn_s_sleep(1); \
    if ((++_sp & 255u) == 0u) { if (xb_ld(&(bar)[XB_TMO])) break; if (_sp > XB_SPIN_CAP) { atomicAdd(&(bar)[XB_TMO], 1u); break; } } } } while (0)
struct XcdBarrier { unsigned* bar; unsigned x; volatile LAS unsigned* st; };
__device__ __forceinline__ XcdBarrier xcd_barrier_post(unsigned* bar, volatile LAS unsigned* st) {
    XcdBarrier b; b.bar = bar; b.x = xb_xcc_id(); b.st = st;
    if (threadIdx.x == 0) (void)xb_add(&bar[XB_XCNT(b.x)], 1u);
    return b;
}
__device__ __forceinline__ void xcd_barrier_complete(unsigned* bar, unsigned x, unsigned& nloc, unsigned& nx) {
    const unsigned G = gridDim.x * gridDim.y * gridDim.z;
    unsigned sum, cnt, mine, sp = 0u;
    for (;;) {
        sum = 0u; cnt = 0u; mine = 0u;
#pragma unroll
        for (unsigned j = 0; j < 16; ++j) { const unsigned c = xb_ld(&bar[XB_XCNT(j)]); sum += c; cnt += (c > 0u) ? 1u : 0u; mine = (j == x) ? c : mine; }
        if (sum == G) break;
        __builtin_amdgcn_s_sleep(1);
        if ((++sp & 255u) == 0u) { if (xb_ld(&bar[XB_TMO])) break; if (sp > XB_SPIN_CAP) { atomicAdd(&bar[XB_TMO], 1u); break; } }
    }
    nloc = mine > 0u ? mine : 1u; nx = cnt > 0u ? cnt : 1u;
}
__device__ __forceinline__ void xcd_barrier(const XcdBarrier& b) {
    asm volatile("s_waitcnt vmcnt(0)" ::: "memory");
    __syncthreads();
    if (threadIdx.x == 0) {
        unsigned* bar = b.bar;
        __builtin_amdgcn_s_waitcnt(0);
        unsigned nloc = b.st[0], nx = b.st[1];
        if (nloc == 0u) { xcd_barrier_complete(bar, b.x, nloc, nx); b.st[0] = nloc; b.st[1] = nx; }
        const unsigned old = xb_add(&bar[XB_XSUB(b.x)], 1u);
        const unsigned gen = old / nloc;
        if (old + 1u == (gen + 1u) * nloc) {
            __builtin_amdgcn_fence(__ATOMIC_RELEASE, "agent");
            asm volatile("s_waitcnt vmcnt(0)" ::: "memory");
            const unsigned og = xb_add(&bar[XB_TOP], 1u);
            const unsigned tg = og / nx;
            if (og + 1u == (tg + 1u) * nx) xb_add(&bar[XB_TOPGEN], 1u);
            else XB_SPIN(xb_ld(&bar[XB_TOPGEN]) == tg, bar);
            __builtin_amdgcn_fence(__ATOMIC_ACQUIRE, "agent");
            xb_add(&bar[XB_XGEN(b.x)], 1u);
            asm volatile("s_waitcnt vmcnt(0)" ::: "memory");
        } else {
            XB_SPIN(xb_ld(&bar[XB_XGEN(b.x)]) == gen, bar);
            __builtin_amdgcn_fence(__ATOMIC_ACQUIRE, "agent");
            asm volatile("s_waitcnt vmcnt(0)" ::: "memory");
        }
    }
    __syncthreads();
}

__device__ __forceinline__ float wave_sum(float v) {
#pragma unroll
    for (int o = 1; o < 64; o <<= 1) v += __shfl_xor(v, o);
    return v;
}
__device__ __forceinline__ void transpose_item(const float* W, int K, int N, bf16* WT, int k0, int n0, int drow0, LAS float* scr, int lane, const float* gain = nullptr) {
    const int c = lane & 7, rq = lane >> 3;
    const GAS float* src = (const GAS float*)W + (size_t)(k0 + rq) * N + n0 + 4 * c;
    f32x4 v[8];
#pragma unroll
    for (int i = 0; i < 8; ++i) v[i] = *(const GAS f32x4*)(src + (size_t)(8 * i) * N);
    f32x4 g0 = (f32x4){1.f, 1.f, 1.f, 1.f}, g1 = g0;
    if (gain) { g0 = *(const GAS f32x4*)((const GAS float*)gain + k0 + 8 * c); g1 = *(const GAS f32x4*)((const GAS float*)gain + k0 + 8 * c + 4); }
#pragma unroll
    for (int i = 0; i < 8; ++i) { LAS float* d = scr + (8 * i + rq) * 33 + 4 * c; d[0] = v[i].x; d[1] = v[i].y; d[2] = v[i].z; d[3] = v[i].w; }
    LDS_WAIT(); asm volatile("" ::: "memory");
#pragma unroll
    for (int j = 0; j < 4; ++j) { const int n = rq + 8 * j; const LAS float* s = scr + (8 * c) * 33 + n;
        u32x4 o; o.x = pk2(s[0 * 33] * g0.x, s[1 * 33] * g0.y); o.y = pk2(s[2 * 33] * g0.z, s[3 * 33] * g0.w); o.z = pk2(s[4 * 33] * g1.x, s[5 * 33] * g1.y); o.w = pk2(s[6 * 33] * g1.z, s[7 * 33] * g1.w);
        *(GAS u32x4*)(WT + (size_t)(drow0 + n) * K + k0 + 8 * c) = o; }
    LDS_WAIT(); asm volatile("" ::: "memory");
}
__device__ __forceinline__ void rms_row_to_bf16(const float* xrow, const float* gain, bf16* orow, int lane) {
    const GAS f32x4* xr = (const GAS f32x4*)xrow + lane; const GAS f32x4* gr = (const GAS f32x4*)gain + lane;
    f32x4 v[8]; float s = 0.f;
#pragma unroll
    for (int j = 0; j < 8; ++j) { v[j] = xr[64 * j]; s += (v[j].x * v[j].x + v[j].y * v[j].y) + (v[j].z * v[j].z + v[j].w * v[j].w); }
    const float r = 1.0f / sqrtf(wave_sum(s) * (1.0f / DM) + EPS);
    GAS u32x2* o8 = (GAS u32x2*)orow + lane;
#pragma unroll
    for (int j = 0; j < 8; ++j) { const f32x4 g = gr[64 * j]; u32x2 w; w.x = pk2(v[j].x * r * g.x, v[j].y * r * g.y); w.y = pk2(v[j].z * r * g.z, v[j].w * r * g.w); o8[64 * j] = w; }
}

__device__ __forceinline__ double d_exp(double x) {
    const double k = __builtin_rint(x * 1.4426950408889634074); const double r = (x - k * 0.693147180369123816490) - k * 1.90821492927058770002e-10;
    double p = 1.0 / 6227020800.0;
    p = p * r + 1.0 / 479001600.0; p = p * r + 1.0 / 39916800.0; p = p * r + 1.0 / 3628800.0; p = p * r + 1.0 / 362880.0; p = p * r + 1.0 / 40320.0; p = p * r + 1.0 / 5040.0;
    p = p * r + 1.0 / 720.0; p = p * r + 1.0 / 120.0; p = p * r + 1.0 / 24.0; p = p * r + 1.0 / 6.0; p = p * r + 0.5; p = p * r + 1.0; p = p * r + 1.0;
    const long long ki = (long long)k; const double sc = __builtin_bit_cast(double, (unsigned long long)(ki + 1023) << 52);
    return p * sc;
}
__device__ __forceinline__ void d_sincos(double x, double& s, double& c) {
    const double k = __builtin_rint(x * 0.63661977236758134308); const double r = (x - k * 1.57079632673412561417) - k * 6.07710050650619224932e-11;
    const double r2 = r * r;
    double ps = -1.0 / 121645100408832000.0;
    ps = ps * r2 + 1.0 / 355687428096000.0; ps = ps * r2 - 1.0 / 1307674368000.0; ps = ps * r2 + 1.0 / 6227020800.0; ps = ps * r2 - 1.0 / 39916800.0; ps = ps * r2 + 1.0 / 362880.0;
    ps = ps * r2 - 1.0 / 5040.0; ps = ps * r2 + 1.0 / 120.0; ps = ps * r2 - 1.0 / 6.0; ps = ps * r2 + 1.0; ps = ps * r;
    double pc = 1.0 / 6402373705728000.0;
    pc = -pc; pc = pc * r2 + 1.0 / 20922789888000.0; pc = pc * r2 - 1.0 / 87178291200.0; pc = pc * r2 + 1.0 / 479001600.0; pc = pc * r2 - 1.0 / 3628800.0; pc = pc * r2 + 1.0 / 40320.0;
    pc = pc * r2 - 1.0 / 720.0; pc = pc * r2 + 1.0 / 24.0; pc = pc * r2 - 0.5; pc = pc * r2 + 1.0;
    const int q = ((int)k) & 3;
    s = (q == 0) ? ps : (q == 1) ? pc : (q == 2) ? -ps : -pc;
    c = (q == 0) ? pc : (q == 1) ? -ps : (q == 2) ? -pc : ps;
}

__device__ __forceinline__ void sb_attn_wave(const bf16* PROJ_, const bf16* VT_, bf16* TOK_, const u64* rss_, int b, int h, int qt2, int lane, LAS unsigned char* stg) {
    const GAS bf16* PROJ = (const GAS bf16*)PROJ_; const GAS bf16* VT = (const GAS bf16*)VT_; GAS bf16* TOK = (GAS bf16*)TOK_;
    const GAS u64* RS = (const GAS u64*)rss_ + (size_t)b * SEQ;
    const int fr = lane & 15, fq = lane >> 4;
    const int t0 = qt2 * 32;
    const size_t rowbase = (size_t)b * SEQ;
    bf16x8 qf[2][4]; float scl[2]; int tq[2];
#pragma unroll
    for (int qi = 0; qi < 2; ++qi) { tq[qi] = t0 + 16 * qi + fr;
        const GAS bf16* qp = PROJ + (rowbase + tq[qi]) * PROJ_SB + h * HD + 8 * fq;
#pragma unroll
        for (int ks = 0; ks < 4; ++ks) qf[qi][ks] = *(const GAS bf16x8*)(qp + 32 * ks);
        scl[qi] = (0.08838834764831845f * 1.4426950408889634f) * __builtin_amdgcn_rsqf(rss2f(RS[tq[qi]]) * (1.0f / DM) + EPS); }
    f32x4 o[2][8];
#pragma unroll
    for (int qi = 0; qi < 2; ++qi)
#pragma unroll
        for (int dt = 0; dt < 8; ++dt) o[qi][dt] = (f32x4){0.f, 0.f, 0.f, 0.f};
    float C[2] = {0.f, 0.f};
    const GAS bf16* kbase = PROJ + (rowbase + 8 * (fr >> 2) + (fr & 3)) * PROJ_SB + TOKW + h * HD + 8 * fq;
    const GAS bf16* vbase = VT + (size_t)(h * HD + fr) * M + rowbase + 8 * fq;
#pragma unroll 1
    for (int kp = t0 >> 5; kp >= 0; --kp) {
        const int kb = kp * 32;
        f32x4 s[2][2];
#pragma unroll
        for (int qi = 0; qi < 2; ++qi) { s[qi][0] = (f32x4){0.f, 0.f, 0.f, 0.f}; s[qi][1] = (f32x4){0.f, 0.f, 0.f, 0.f}; }
        const GAS bf16* k0p = kbase + (size_t)kb * PROJ_SB; const GAS bf16* k1p = k0p + (size_t)4 * PROJ_SB;
#pragma unroll
        for (int ks = 0; ks < 4; ++ks) { const bf16x8 k0 = *(const GAS bf16x8*)(k0p + 32 * ks), k1 = *(const GAS bf16x8*)(k1p + 32 * ks);
#pragma unroll
            for (int qi = 0; qi < 2; ++qi) { s[qi][0] = mfma16(k0, qf[qi][ks], s[qi][0]); s[qi][1] = mfma16(k1, qf[qi][ks], s[qi][1]); } }
        bf16x8 vf[8];
#pragma unroll
        for (int dt = 0; dt < 8; ++dt) vf[dt] = *(const GAS bf16x8*)(vbase + (size_t)(16 * dt) * M + kb);
        float rk[2][4];
#pragma unroll
        for (int T = 0; T < 2; ++T)
#pragma unroll
            for (int r = 0; r < 4; ++r) rk[T][r] = __builtin_amdgcn_rsqf(rss2f(RS[kb + 8 * fq + 4 * T + r]) * (1.0f / DM) + EPS);
#pragma unroll
        for (int qi = 0; qi < 2; ++qi) {
            float ln[2][4], zz[2][4]; bool valid[2][4];
#pragma unroll
            for (int T = 0; T < 2; ++T)
#pragma unroll
                for (int r = 0; r < 4; ++r) { const float z = s[qi][T][r] * scl[qi] * rk[T][r]; valid[T][r] = (kb + 8 * fq + 4 * T + r) < tq[qi];
                    const float e = __builtin_amdgcn_exp2f(-fabsf(z)); const float sp = fmaxf(z, 0.f) + __builtin_amdgcn_logf(1.0f + e);
                    ln[T][r] = valid[T][r] ? -sp : 0.f; zz[T][r] = z; }
            float suf[2][4], tot[2];
#pragma unroll
            for (int T = 0; T < 2; ++T) { suf[T][3] = 0.f; suf[T][2] = ln[T][3]; suf[T][1] = ln[T][3] + ln[T][2]; suf[T][0] = suf[T][1] + ln[T][1]; tot[T] = suf[T][0] + ln[T][0]; }
            const float lt = tot[0] + tot[1];
            const float t1 = __shfl_down(lt, 16), t2 = __shfl_down(lt, 32), t3 = __shfl_down(lt, 48);
            const float higher = (fq < 3 ? t1 : 0.f) + (fq < 2 ? t2 : 0.f) + (fq < 1 ? t3 : 0.f);
            float ta = lt + __shfl_xor(lt, 16); ta += __shfl_xor(ta, 32);
            const float base1 = C[qi] + higher, base0 = base1 + tot[1];
            float w[2][4];
#pragma unroll
            for (int r = 0; r < 4; ++r) { w[0][r] = valid[0][r] ? __builtin_amdgcn_exp2f(zz[0][r] + ln[0][r] + base0 + suf[0][r]) * rk[0][r] : 0.f;
                                          w[1][r] = valid[1][r] ? __builtin_amdgcn_exp2f(zz[1][r] + ln[1][r] + base1 + suf[1][r]) * rk[1][r] : 0.f; }
            C[qi] += ta;
            union { bf16x8 v; unsigned u[4]; } pf;
            pf.u[0] = cvt_pk_bf16(w[0][0], w[0][1]); pf.u[1] = cvt_pk_bf16(w[0][2], w[0][3]); pf.u[2] = cvt_pk_bf16(w[1][0], w[1][1]); pf.u[3] = cvt_pk_bf16(w[1][2], w[1][3]);
#pragma unroll
            for (int dt = 0; dt < 8; ++dt) o[qi][dt] = mfma16(vf[dt], pf.v, o[qi][dt]);
        }
        if (__all(C[0] < -57.70780163555854f && C[1] < -57.70780163555854f)) break;
    }
#pragma unroll
    for (int qi = 0; qi < 2; ++qi) { LAS unsigned char* sp = stg + (16 * qi + fr) * 272 + 8 * fq;
#pragma unroll
        for (int dt = 0; dt < 8; ++dt) { u32x2 w; w.x = cvt_pk_bf16(o[qi][dt][0], o[qi][dt][1]); w.y = cvt_pk_bf16(o[qi][dt][2], o[qi][dt][3]); *(LAS u32x2*)(sp + 32 * dt) = w; } }
    {
        u32x4 w[8];
#pragma unroll
        for (int i = 0; i < 8; ++i) w[i] = *(LAS u32x4*)(stg + (4 * i + fq) * 272 + 16 * fr);
        GAS bf16* op = TOK + (rowbase + t0 + fq) * DM + h * HD + 8 * fr;
#pragma unroll
        for (int i = 0; i < 8; ++i) *(GAS u32x4*)(op + (size_t)(4 * i) * DM) = w[i];
    }
}

__device__ __forceinline__ void cross_attn_wave(const bf16* PROJ_, int ldp, int qoff, LAS unsigned char* lds, bf16* TOK_, const u64* rss_, int b, int hm, int qt2, int lane) {
    const GAS bf16* PROJ = (const GAS bf16*)PROJ_; GAS bf16* TOK = (GAS bf16*)TOK_;
    const int fr = lane & 15, fq = lane >> 4;
    bf16x8 qf[2][4]; float rq[2]; size_t row[2];
#pragma unroll
    for (int qi = 0; qi < 2; ++qi) { row[qi] = (size_t)b * SEQ + qt2 * 32 + 16 * qi + fr; float ss = 0.f;
        const GAS bf16* qp = PROJ + row[qi] * ldp + qoff + hm * HD + 8 * fq;
#pragma unroll
        for (int ks = 0; ks < 4; ++ks) { qf[qi][ks] = *(const GAS bf16x8*)(qp + 32 * ks);
#pragma unroll
            for (int j = 0; j < 8; ++j) { const float q = bf2f((unsigned short)qf[qi][ks][j]); ss += q * q; } }
        ss += __shfl_xor(ss, 16); ss += __shfl_xor(ss, 32);
        const float eps2 = EPS * (rss2f(((const GAS u64*)rss_)[row[qi]]) * (1.0f / DM) + EPS);
        rq[qi] = (1.0f / sqrtf(ss * (1.0f / HD) + eps2)) * (0.08838834764831845f * 1.4426950408889634f); }
    f32x4 o[2][8];
#pragma unroll
    for (int qi = 0; qi < 2; ++qi)
#pragma unroll
        for (int dt = 0; dt < 8; ++dt) o[qi][dt] = (f32x4){0.f, 0.f, 0.f, 0.f};
    float mrun[2] = {-1e30f, -1e30f}, lrun[2] = {0.f, 0.f};
    LAS unsigned char* kbase = lds + (8 * (fr >> 2) + (fr & 3)) * XK_ROWB + 16 * fq;
    LAS unsigned char* vbase = lds + XV_OFF + fr * XV_ROWB + 16 * fq;
#pragma unroll 1
    for (int kp = 0; kp < 8; ++kp) {
        const int kb = kp * 32;
        f32x4 s[2][2];
#pragma unroll
        for (int qi = 0; qi < 2; ++qi) { s[qi][0] = (f32x4){0.f, 0.f, 0.f, 0.f}; s[qi][1] = (f32x4){0.f, 0.f, 0.f, 0.f}; }
#pragma unroll
        for (int ks = 0; ks < 4; ++ks) { const bf16x8 k0 = *(const LAS bf16x8*)(kbase + kb * XK_ROWB + 64 * ks), k1 = *(const LAS bf16x8*)(kbase + (kb + 4) * XK_ROWB + 64 * ks);
#pragma unroll
            for (int qi = 0; qi < 2; ++qi) { s[qi][0] = mfma16(k0, qf[qi][ks], s[qi][0]); s[qi][1] = mfma16(k1, qf[qi][ks], s[qi][1]); } }
        bf16x8 vf[8];
#pragma unroll
        for (int dt = 0; dt < 8; ++dt) vf[dt] = *(const LAS bf16x8*)(vbase + 16 * dt * XV_ROWB + 2 * kb);
#pragma unroll
        for (int qi = 0; qi < 2; ++qi) {
            float mx = -1e30f;
#pragma unroll
            for (int r = 0; r < 4; ++r) { s[qi][0][r] *= rq[qi]; s[qi][1][r] *= rq[qi]; mx = fmaxf(mx, fmaxf(s[qi][0][r], s[qi][1][r])); }
            mx = fmaxf(mx, __shfl_xor(mx, 16)); mx = fmaxf(mx, __shfl_xor(mx, 32));
            if (__any(mx > mrun[qi] + 8.0f)) {
                const float mnew = fmaxf(mrun[qi], mx), corr = __builtin_amdgcn_exp2f(mrun[qi] - mnew);
#pragma unroll
                for (int dt = 0; dt < 8; ++dt) o[qi][dt] = o[qi][dt] * corr;
                lrun[qi] *= corr; mrun[qi] = mnew; }
            const float mref = mrun[qi];
            float p0[4], p1[4], ps = 0.f;
#pragma unroll
            for (int r = 0; r < 4; ++r) { p0[r] = __builtin_amdgcn_exp2f(s[qi][0][r] - mref); p1[r] = __builtin_amdgcn_exp2f(s[qi][1][r] - mref); ps += p0[r] + p1[r]; }
            ps += __shfl_xor(ps, 16); ps += __shfl_xor(ps, 32);
            lrun[qi] += ps;
            union { bf16x8 v; unsigned u[4]; } pf;
            pf.u[0] = cvt_pk_bf16(p0[0], p0[1]); pf.u[1] = cvt_pk_bf16(p0[2], p0[3]); pf.u[2] = cvt_pk_bf16(p1[0], p1[1]); pf.u[3] = cvt_pk_bf16(p1[2], p1[3]);
#pragma unroll
            for (int dt = 0; dt < 8; ++dt) o[qi][dt] = mfma16(vf[dt], pf.v, o[qi][dt]);
        }
    }
#pragma unroll
    for (int qi = 0; qi < 2; ++qi) { const float inv = 1.0f / lrun[qi];
        GAS bf16* op = TOK + row[qi] * DM + TOKW + hm * HD + 4 * fq;
#pragma unroll
        for (int dt = 0; dt < 8; ++dt) { u32x2 w; w.x = cvt_pk_bf16(o[qi][dt][0] * inv, o[qi][dt][1] * inv); w.y = cvt_pk_bf16(o[qi][dt][2] * inv, o[qi][dt][3] * inv); *(GAS u32x2*)(op + 16 * dt) = w; } }
}

constexpr int S5_LDS_WAVE = 12800;
template <int PASS>
__device__ __forceinline__ void s5_wave(const bf16* PROJ_, const bf16* Bbar_, const bf16* Ccat_, const float* ABAR_, const float* dskip_, float* E_, bf16* Y_, const u64* rss_,
                                        int b, int g, int c, LAS unsigned char* wl, int lane) {
    const GAS bf16* PROJ = (const GAS bf16*)PROJ_; const GAS bf16* Bbar = (const GAS bf16*)Bbar_; const GAS bf16* Ccat = (const GAS bf16*)Ccat_;
    const GAS float* ABAR = (const GAS float*)ABAR_; const GAS float* dskip = (const GAS float*)dskip_; GAS float* E = (GAS float*)E_; GAS bf16* Y = (GAS bf16*)Y_;
    const int fr = lane & 15, fq = lane >> 4;
    LAS float* BUs = (LAS float*)wl; LAS bf16* Ss = (LAS bf16*)(wl + 8448);
    const bf16x8 zero8 = (bf16x8){0, 0, 0, 0, 0, 0, 0, 0};
    const size_t row0 = (size_t)b * SEQ + (size_t)c * S5T;
    const GAS bf16* up = PROJ + (row0 + fr) * PROJ_S5 + g * 16;
    const GAS u64* RS = (const GAS u64*)rss_ + row0 + fr;
    bf16x8 ufn = *(const GAS bf16x8*)(up + 8 * (fq & 1)); bf16x4 u4n = *(const GAS bf16x4*)(up + 4 * fq); u64 rsn = RS[0];
    bf16x8 bb[8];
#pragma unroll
    for (int mt = 0; mt < 8; ++mt) { const bf16x8 t = *(const GAS bf16x8*)(Bbar + ((size_t)g * 128 + 16 * mt + fr) * 16 + 8 * (fq & 1)); bb[mt] = (fq < 2) ? t : zero8; }
    const f32x4 ab = *(const GAS f32x4*)(ABAR + ((size_t)g * 64 + lane) * 4);
    bf16x8 cc[4]; f32x4 dv = (f32x4){0.f, 0.f, 0.f, 0.f};
    if (PASS == 1) {
#pragma unroll
        for (int ks = 0; ks < 4; ++ks) cc[ks] = *(const GAS bf16x8*)(Ccat + ((size_t)g * 16 + fr) * 128 + 32 * ks + 8 * fq);
        dv = *(const GAS f32x4*)(dskip + g * 16 + 4 * fq);
    }
    float sre = 0.f, sim = 0.f;
    const f32x2 a00 = (f32x2){ab[0], ab[0]}, a11 = (f32x2){-ab[1], ab[1]};
    GAS float* Ebg = E + ((size_t)(b * S5G + g) * S5NC) * 128;
    if (PASS == 1) {
        int jc = 0;
#pragma unroll 1
        for (; jc + 8 <= c; jc += 8) { f32x2 e[8];
#pragma unroll
            for (int k = 0; k < 8; ++k) e[k] = *(const GAS f32x2*)(Ebg + (size_t)(jc + k) * 128 + 2 * lane);
#pragma unroll
            for (int k = 0; k < 8; ++k) { const float nre = ab[2] * sre - ab[3] * sim + e[k].x, nim = ab[2] * sim + ab[3] * sre + e[k].y; sre = nre; sim = nim; } }
#pragma unroll 1
        for (; jc < c; ++jc) { const f32x2 e = *(const GAS f32x2*)(Ebg + (size_t)jc * 128 + 2 * lane);
            const float nre = ab[2] * sre - ab[3] * sim + e.x, nim = ab[2] * sim + ab[3] * sre + e.y; sre = nre; sim = nim; }
    }
#pragma unroll 1
    for (int sb = 0; sb < S5T / 16; ++sb) {
          const bf16x8 uf = ufn; const bf16x4 u4 = u4n; const float rt = __builtin_amdgcn_rsqf(rss2f(rsn) * (1.0f / DM) + EPS);
        if (sb < S5T / 16 - 1) { const GAS bf16* un = up + (size_t)(sb + 1) * 16 * PROJ_S5;
            ufn = *(const GAS bf16x8*)(un + 8 * (fq & 1)); u4n = *(const GAS bf16x4*)(un + 4 * fq); rsn = RS[(sb + 1) * 16]; }
#pragma unroll
        for (int mt = 0; mt < 8; ++mt) { const f32x4 bu = mfma16(bb[mt], uf, (f32x4){0.f, 0.f, 0.f, 0.f}) * rt;
            *(LAS f32x4*)(BUs + fr * 132 + 16 * mt + 4 * fq) = bu; }
        LDS_WAIT(); asm volatile("" ::: "memory");
        f32x2 bt[16];
#pragma unroll
        for (int t = 0; t < 16; ++t) bt[t] = *(const LAS f32x2*)(BUs + t * 132 + 2 * lane);
        LDS_WAIT(); asm volatile("" ::: "memory");
        f32x2 sv = (f32x2){sre, sim};
#pragma unroll
        for (int t = 0; t < 16; ++t) {
            f32x2 tt, s2;
            asm("v_pk_fma_f32 %0, %1, %2, %3" : "=v"(tt) : "v"(a00), "v"(sv), "v"(bt[t]));
            asm("v_pk_fma_f32 %0, %1, %2, %3 op_sel:[0,1,0] op_sel_hi:[1,0,1]" : "=v"(s2) : "v"(a11), "v"(sv), "v"(tt));
            sv = s2;
            if (PASS == 1) *(LAS unsigned*)(Ss + t * 136 + 2 * lane) = cvt_pk_bf16(sv.x, sv.y); }
        sre = sv.x; sim = sv.y;
        if (PASS == 1) {
            LDS_WAIT(); asm volatile("" ::: "memory");
            f32x4 y = (f32x4){0.f, 0.f, 0.f, 0.f};
#pragma unroll
            for (int ks = 0; ks < 4; ++ks) { const bf16x8 sf = *(const LAS bf16x8*)(Ss + fr * 136 + 32 * ks + 8 * fq); y = mfma16(cc[ks], sf, y); }
            f32x2 v2[2], e2[2];
#pragma unroll
            for (int q = 0; q < 2; ++q) { const f32x2 uu = (f32x2){bf2f((unsigned short)u4[2 * q]), bf2f((unsigned short)u4[2 * q + 1])} * rt;
                v2[q] = (f32x2){y[2 * q], y[2 * q + 1]} + (f32x2){dv[2 * q], dv[2 * q + 1]} * uu;
                const f32x2 vv = v2[q] * v2[q]; e2[q] = (v2[q] * (-2.0f * 0.7978845608028654f * 1.4426950408889634f)) * (vv * 0.044715f + 1.0f); }
#pragma unroll
            for (int q = 0; q < 2; ++q) { e2[q].x = __builtin_amdgcn_exp2f(e2[q].x); e2[q].y = __builtin_amdgcn_exp2f(e2[q].y); }
#pragma unroll
            for (int q = 0; q < 2; ++q) e2[q] = e2[q] + 1.0f;
#pragma unroll
            for (int q = 0; q < 2; ++q) { e2[q].x = __builtin_amdgcn_rcpf(e2[q].x); e2[q].y = __builtin_amdgcn_rcpf(e2[q].y); }
            const f32x2 o0 = v2[0] * e2[0], o1 = v2[1] * e2[1];
            u32x2 w; w.x = cvt_pk_bf16(o0.x, o0.y); w.y = cvt_pk_bf16(o1.x, o1.y);
            *(GAS u32x2*)(Y + (row0 + sb * 16 + fr) * TOKW + g * 16 + 4 * fq) = w;
        }
        LDS_WAIT(); asm volatile("" ::: "memory");
        __builtin_amdgcn_sched_barrier(0);
        asm volatile("" : "+v"(ufn), "+v"(u4n), "+v"(rsn));
    }
    if (PASS == 0) *(GAS f32x2*)(Ebg + (size_t)c * 128 + 2 * lane) = (f32x2){sre, sim};
}

__device__ __forceinline__ void s5_pass0_wave(const bf16* PROJ_, const bf16* Bbar_, const float* ABAR_, float* E_, const u64* rss_, int b, int g, int c, LAS unsigned char* wl, int lane) {
    const GAS bf16* PROJ = (const GAS bf16*)PROJ_; const GAS bf16* Bbar = (const GAS bf16*)Bbar_; const GAS float* ABAR = (const GAS float*)ABAR_; GAS float* E = (GAS float*)E_;
    const int fr = lane & 15, fq = lane >> 4;
    const bf16x8 zero8 = (bf16x8){0, 0, 0, 0, 0, 0, 0, 0};
    const size_t row0 = (size_t)b * SEQ + (size_t)c * S5T;
    const GAS bf16* up = PROJ + (row0 + fr) * PROJ_S5 + g * 16 + 8 * (fq & 1);
    bf16x8 ufn[4];
#pragma unroll
    for (int i = 0; i < 4; ++i) ufn[i] = *(const GAS bf16x8*)(up + (size_t)i * 16 * PROJ_S5);
    LAS float* rtl = (LAS float*)wl;
    {
        const GAS u64* RS = (const GAS u64*)rss_ + row0 + 4 * lane;
        const u64 r0 = RS[0], r1 = RS[1], r2 = RS[2], r3 = RS[3];
        f32x4 rv; rv[0] = __builtin_amdgcn_rsqf(rss2f(r0) * (1.0f / DM) + EPS); rv[1] = __builtin_amdgcn_rsqf(rss2f(r1) * (1.0f / DM) + EPS);
        rv[2] = __builtin_amdgcn_rsqf(rss2f(r2) * (1.0f / DM) + EPS); rv[3] = __builtin_amdgcn_rsqf(rss2f(r3) * (1.0f / DM) + EPS);
        *(LAS f32x4*)(rtl + 4 * lane) = rv;
    }
    bf16x8 bre[4], bim[4];
    float are[4], aim[4], gre[4], gim[4];
#pragma unroll
    for (int j = 0; j < 4; ++j) { const GAS bf16* bp = Bbar + ((size_t)g * 128 + 2 * (16 * j + fr)) * 16 + 8 * (fq & 1);
        const bf16x8 t0 = *(const GAS bf16x8*)bp, t1 = *(const GAS bf16x8*)(bp + 16); bre[j] = (fq < 2) ? t0 : zero8; bim[j] = (fq < 2) ? t1 : zero8;
        const f32x2 a = *(const GAS f32x2*)(ABAR + ((size_t)g * 64 + 16 * j + fr) * 4);
        are[j] = a.x; aim[j] = a.y;
        const float a2r = a.x * a.x - a.y * a.y, a2i = 2.0f * a.x * a.y;
        const float a4r = a2r * a2r - a2i * a2i, a4i = 2.0f * a2r * a2i;
        const float a8r = a4r * a4r - a4i * a4i, a8i = 2.0f * a4r * a4i;
        const float a12r = a8r * a4r - a8i * a4i, a12i = a8r * a4i + a8i * a4r;
        gre[j] = a12r * a.x - a12i * a.y; gim[j] = a12r * a.y + a12i * a.x; }
    float Rre[4] = {0.f, 0.f, 0.f, 0.f}, Rim[4] = {0.f, 0.f, 0.f, 0.f};
    LDS_WAIT(); asm volatile("" ::: "memory");
#pragma unroll 1
    for (int h = 0; h < S5T / 64; ++h) {
      bf16x8 ufc[4];
#pragma unroll
      for (int i = 0; i < 4; ++i) ufc[i] = ufn[i];
      if (h < S5T / 64 - 1) {
#pragma unroll
          for (int i = 0; i < 4; ++i) ufn[i] = *(const GAS bf16x8*)(up + (size_t)((h + 1) * 4 + i) * 16 * PROJ_S5); }
#pragma unroll
      for (int i = 0; i < 4; ++i) { const int sb = h * 4 + i;
        const bf16x8 uf = ufc[i];
        const f32x4 rt = *(const LAS f32x4*)(rtl + 16 * sb + 4 * fq);
#pragma unroll
        for (int j = 0; j < 4; ++j) {
            const f32x4 br = mfma16(uf, bre[j], (f32x4){0.f, 0.f, 0.f, 0.f}) * rt, bi = mfma16(uf, bim[j], (f32x4){0.f, 0.f, 0.f, 0.f}) * rt;
            float nr = __builtin_fmaf(-gim[j], Rim[j], __builtin_fmaf(gre[j], Rre[j], br[0])), ni = __builtin_fmaf(gim[j], Rre[j], __builtin_fmaf(gre[j], Rim[j], bi[0]));
#pragma unroll
            for (int r = 1; r < 4; ++r) { const float tr = __builtin_fmaf(-aim[j], ni, __builtin_fmaf(are[j], nr, br[r])), ti = __builtin_fmaf(aim[j], nr, __builtin_fmaf(are[j], ni, bi[r])); nr = tr; ni = ti; }
            Rre[j] = nr; Rim[j] = ni; }
        __builtin_amdgcn_sched_barrier(0);
      }
      asm volatile("" : "+v"(ufn[0]), "+v"(ufn[1]), "+v"(ufn[2]), "+v"(ufn[3]));
    }
    float ore = 0.f, oim = 0.f;
#pragma unroll
    for (int j = 0; j < 4; ++j) {
        const float a2r = are[j] * are[j] - aim[j] * aim[j], a2i = 2.0f * are[j] * aim[j];
        const float a4r = a2r * a2r - a2i * a2i, a4i = 2.0f * a2r * a2i;
        const float a8r = a4r * a4r - a4i * a4i, a8i = 2.0f * a4r * a4i;
        const float a12r = a8r * a4r - a8i * a4i, a12i = a8r * a4i + a8i * a4r;
        const float wr = fq == 0 ? a12r : fq == 1 ? a8r : fq == 2 ? a4r : 1.0f, wi = fq == 0 ? a12i : fq == 1 ? a8i : fq == 2 ? a4i : 0.0f;
        float xr = wr * Rre[j] - wi * Rim[j], xi = wr * Rim[j] + wi * Rre[j];
        xr += __shfl_xor(xr, 16); xi += __shfl_xor(xi, 16); xr += __shfl_xor(xr, 32); xi += __shfl_xor(xi, 32);
        if (fq == j) { ore = xr; oim = xi; } }
    *(GAS f32x2*)(E + ((size_t)(b * S5G + g) * S5NC + c) * 128 + 2 * lane) = (f32x2){ore, oim};
}

struct Args { const float* in[25]; float* out; unsigned char* ws; };
enum { I_X = 0, I_MEM, I_F1N, I_F1GU, I_F1DN, I_MIXN, I_MEMN, I_WKV, I_XQN, I_XKN, I_WOUT, I_F2N, I_F2GU, I_F2DN, I_SBIN, I_S5IN, I_LOGDT, I_ARE, I_AIM, I_BRE, I_BIM, I_CRE, I_CIM, I_S5D, I_WGLU };

__device__ __forceinline__ void cross_attn_phase(const bf16* PROJ, int ldp, int qoff, const bf16* KNl, const bf16* VTMl, bf16* TOK, const u64* rss, LAS unsigned char* lds, int vcu, int G, int tid, int wave, int lane) {
#pragma unroll 1
    for (int base = vcu * 8; base < BATCH * MEMHEADS * (SEQ / 32); base += G * 8) {
        const int bh = base >> 8;
        const GAS bf16* kn = (const GAS bf16*)KNl + (size_t)bh * NMEM * HD; const GAS bf16* vt = (const GAS bf16*)VTMl + (size_t)bh * HD * NMEM;
        __syncthreads();
        { u32x4 kv[8], vv[8];
#pragma unroll
          for (int it = 0; it < 8; ++it) { const int ch = tid + 512 * it; kv[it] = *(const GAS u32x4*)(kn + (size_t)(ch >> 4) * HD + 8 * (ch & 15)); vv[it] = *(const GAS u32x4*)(vt + (size_t)(ch >> 5) * NMEM + 8 * (ch & 31)); }
#pragma unroll
          for (int it = 0; it < 8; ++it) { const int ch = tid + 512 * it; *(LAS u32x4*)(lds + (ch >> 4) * XK_ROWB + 16 * (ch & 15)) = kv[it]; *(LAS u32x4*)(lds + XV_OFF + (ch >> 5) * XV_ROWB + 16 * (ch & 31)) = vv[it]; } }
        asm volatile("s_waitcnt vmcnt(0) lgkmcnt(0)" ::: "memory"); __syncthreads();
        const int v = base + wave; cross_attn_wave(PROJ, ldp, qoff, lds, TOK, rss, bh / MEMHEADS, bh % MEMHEADS, v & 255, lane);
    }
    __syncthreads();
}

#define PHASE_VARS \
    int ptid = threadIdx.x; asm volatile("" : "+v"(ptid)); \
    const int lane = ptid & 63; const int wave = __builtin_amdgcn_readfirstlane(ptid >> 6); \
    const int gw = vcu * 8 + wave; \
    unsigned char* ws = args.ws; asm volatile("" : "+s"(ws)); \
    float* out = args.out; asm volatile("" : "+s"(out)); \
    (void)lane; (void)gw; (void)out;
#define P_WGU1 ((bf16*)(ws + WS_WGU1))
#define P_WDN1 ((bf16*)(ws + WS_WDN1))
#define P_WGU2 ((bf16*)(ws + WS_WGU2))
#define P_WDN2 ((bf16*)(ws + WS_WDN2))
#define P_WOUT ((bf16*)(ws + WS_WOUT))
#define P_WKV ((bf16*)(ws + WS_WKV))
#define P_WINSB ((bf16*)(ws + WS_WINSB))
#define P_WINS5 ((bf16*)(ws + WS_WINS5))
#define P_WGLU ((bf16*)(ws + WS_WGLU))
#define P_XN ((bf16*)(ws + WS_XN))
#define P_ACT ((bf16*)(ws + WS_ACT))
#define P_PROJ ((bf16*)(ws + WS_PROJ))
#define P_VT ((bf16*)(ws + WS_VT))
#define P_YB ((bf16*)(ws + WS_VT))
#define P_TOK ((bf16*)(ws + WS_TOK))
#define P_MEMH ((bf16*)(ws + WS_MEMH))
#define P_KVM ((bf16*)(ws + WS_KVM))
#define P_KN ((bf16*)(ws + WS_KN))
#define P_VTM ((bf16*)(ws + WS_VTM))
#define P_BBAR ((bf16*)(ws + WS_BBAR))
#define P_CCAT ((bf16*)(ws + WS_CCAT))
#define P_ABAR ((float*)(ws + WS_ABAR))
#define P_EB ((float*)(ws + WS_E))
#define P_RSS ((u64*)(ws + WS_RSS))

__global__ void __launch_bounds__(512, 2) fwd(Args args) {
    extern __shared__ __attribute__((aligned(16))) unsigned char lds_raw[];
    LAS unsigned char* lds = (LAS unsigned char*)lds_raw;
    const int G = gridDim.x; const int bx = blockIdx.x; const int vcu = (G % 8 == 0) ? (bx % 8) * (G / 8) + bx / 8 : bx;
    const int NGW = G * 8;
    for (int u = threadIdx.x; u < (LDS_BYTES - LDSCTL_OFF) / 4; u += 512) ((LAS unsigned*)(lds + LDSCTL_OFF))[u] = 0u;
    __syncthreads();
    XcdBarrier bar = xcd_barrier_post((unsigned*)(args.ws + WS_CTL) + CW_BAR, (volatile LAS unsigned*)(lds + MISC_OFF) + 8);
#define GRID_BAR() xcd_barrier(bar)

    {
        PHASE_VARS
        LAS float* scr = (LAS float*)(lds + wave * 16384);
        constexpr int IT_GU = (DM / 64) * (2 * FFN / 32), IT_DN = (FFN / 64) * (DM / 32), IT_OUT = (DM / 64) * (DM / 32), IT_KV = (DM / 64) * (1024 / 32);
        constexpr int IT_INSB = (DM / 64) * (5120 / 32), IT_INS5 = (DM / 64) * (DM / 32), IT_GLU = (TOKW / 64) * (TOKW / 32);
        constexpr int NITEMS = 4 * (2 * IT_GU + 2 * IT_DN + IT_OUT + IT_KV) + 2 * (IT_INSB + IT_INS5 + IT_GLU);
#pragma unroll 1
        for (int it = gw; it < NITEMS; it += NGW) {
            int r = it;
            if (r < 8 * IT_GU) {
                const int which = r / (4 * IT_GU); r -= which * 4 * IT_GU; const int layer = r / IT_GU; r -= layer * IT_GU;
                const int nblk = 2 * FFN / 32, kb = r / nblk, nb = r % nblk, n0 = 32 * nb, bj = n0 / FFN, jj = n0 % FFN, drow0 = 256 * (jj / 128) + 128 * bj + (jj % 128);
                transpose_item(args.in[which ? I_F2GU : I_F1GU] + (size_t)layer * DM * 2 * FFN, DM, 2 * FFN, (which ? P_WGU2 : P_WGU1) + (size_t)layer * 2 * FFN * DM, 64 * kb, n0, drow0, scr, lane, args.in[which ? I_F2N : I_F1N] + (size_t)layer * DM);
                continue; }
            r -= 8 * IT_GU;
            if (r < 8 * IT_DN) {
                const int which = r / (4 * IT_DN); r -= which * 4 * IT_DN; const int layer = r / IT_DN; r -= layer * IT_DN;
                const int nblk = DM / 32, kb = r / nblk, nb = r % nblk;
                transpose_item(args.in[which ? I_F2DN : I_F1DN] + (size_t)layer * FFN * DM, FFN, DM, (which ? P_WDN2 : P_WDN1) + (size_t)layer * DM * FFN, 64 * kb, 32 * nb, 32 * nb, scr, lane);
                continue; }
            r -= 8 * IT_DN;
            if (r < 4 * IT_OUT) {
                const int layer = r / IT_OUT; r -= layer * IT_OUT; const int nblk = DM / 32, kb = r / nblk, nb = r % nblk;
                transpose_item(args.in[I_WOUT] + (size_t)layer * DM * DM, DM, DM, P_WOUT + (size_t)layer * DM * DM, 64 * kb, 32 * nb, 32 * nb, scr, lane);
                continue; }
            r -= 4 * IT_OUT;
            if (r < 4 * IT_KV) {
                const int layer = r / IT_KV; r -= layer * IT_KV; const int nblk = 1024 / 32, kb = r / nblk, nb = r % nblk;
                transpose_item(args.in[I_WKV] + (size_t)layer * DM * 1024, DM, 1024, P_WKV + (size_t)layer * 1024 * DM, 64 * kb, 32 * nb, 32 * nb, scr, lane);
                continue; }
            r -= 4 * IT_KV;
            if (r < 2 * IT_INSB) {
                const int j = r / IT_INSB; r -= j * IT_INSB; const int nblk = 5120 / 32, kb = r / nblk, nb = r % nblk, n0 = 32 * nb;
                const int drow0 = (n0 < 3072) ? n0 : (n0 < 4608 ? n0 + 512 : n0 - 1536);
                transpose_item(args.in[I_SBIN] + (size_t)j * DM * 5120, DM, 5120, P_WINSB + (size_t)j * 5120 * DM, 64 * kb, n0, drow0, scr, lane, args.in[I_MIXN] + (size_t)(2 * j) * DM);
                continue; }
            r -= 2 * IT_INSB;
            if (r < 2 * IT_INS5) {
                const int j = r / IT_INS5; r -= j * IT_INS5; const int nblk = DM / 32, kb = r / nblk, nb = r % nblk;
                transpose_item(args.in[I_S5IN] + (size_t)j * DM * DM, DM, DM, P_WINS5 + (size_t)j * DM * DM, 64 * kb, 32 * nb, 32 * nb, scr, lane, args.in[I_MIXN] + (size_t)(2 * j + 1) * DM);
                continue; }
            r -= 2 * IT_INS5;
            { const int j = r / IT_GLU; r -= j * IT_GLU; const int nblk = TOKW / 32, kb = r / nblk, nb = r % nblk;
              transpose_item(args.in[I_WGLU] + (size_t)j * TOKW * TOKW, TOKW, TOKW, P_WGLU + (size_t)j * TOKW * TOKW, 64 * kb, 32 * nb, 32 * nb, scr, lane); }
        }
#pragma unroll 1
        for (int m = gw; m < 4 * 512; m += NGW) { const int layer = m >> 9, rr = m & 511;
            rms_row_to_bf16(args.in[I_MEM] + (size_t)rr * DM, args.in[I_MEMN] + (size_t)layer * DM, P_MEMH + (size_t)m * DM, lane); }
#pragma unroll 1
        for (int idx = gw * 64 + lane; idx < 2 * S5G * S5N; idx += NGW * 64) {
            const int j = idx / (S5G * S5N), g = (idx / S5N) % S5G, n = idx % S5N;
            const double dt = d_exp((double)args.in[I_LOGDT][j * S5G + g]);
            const double lre = (double)args.in[I_ARE][(j * S5G + g) * S5N + n], lim = (double)args.in[I_AIM][(j * S5G + g) * S5N + n];
            const double ea = d_exp(lre * dt); double sn, cs; d_sincos(lim * dt, sn, cs);
            const double are = ea * cs, aim = ea * sn;
            const double nr = are - 1.0, ni = aim, den = lre * lre + lim * lim;
            const double cre = (nr * lre + ni * lim) / den, cim = (ni * lre - nr * lim) / den;
            const float* bre = args.in[I_BRE] + ((size_t)(j * S5G + g) * S5N + n) * S5C; const float* bim = args.in[I_BIM] + ((size_t)(j * S5G + g) * S5N + n) * S5C;
            bf16* bo = P_BBAR + ((size_t)(j * S5G + g) * 128 + 2 * n) * 16;
#pragma unroll 1
            for (int c = 0; c < S5C; ++c) { const double br = bre[c], bi = bim[c]; bo[c] = (bf16)f2bf((float)(cre * br - cim * bi)); bo[16 + c] = (bf16)f2bf((float)(cre * bi + cim * br)); }
            const float* cr = args.in[I_CRE] + (size_t)(j * S5G + g) * S5C * S5N; const float* ci = args.in[I_CIM] + (size_t)(j * S5G + g) * S5C * S5N;
            bf16* co = P_CCAT + (size_t)(j * S5G + g) * 16 * 128;
#pragma unroll 1
            for (int c = 0; c < S5C; ++c) { co[c * 128 + 2 * n] = (bf16)f2bf(cr[c * S5N + n]); co[c * 128 + 2 * n + 1] = (bf16)f2bf(-ci[c * S5N + n]); }
            double tr = are, ti = aim;
#pragma unroll 1
            for (int s = 0; s < S5T_LOG2; ++s) { const double t2r = tr * tr - ti * ti, t2i = 2.0 * tr * ti; tr = t2r; ti = t2i; }
            *(f32x4*)(P_ABAR + ((size_t)(j * S5G + g) * 64 + n) * 4) = (f32x4){(float)are, (float)aim, (float)tr, (float)ti};
        }
    }
    GRID_BAR();
    {
        PHASE_VARS
        pg8::KvSched S; S.A = (const char*)P_MEMH; S.B = (const char*)P_WKV; S.tstep = (size_t)256 * DM * 2; S.G = G; S.c = bx;
        pg8::EpiBf16 E{P_KVM, 1024, P_KVM, 1024, 3};
        pg8::gemm_phase<pg8::EpiBf16, pg8::KvSched, true, true>(lds, DM, S, E, ptid);
        const int nkv = (G > 64) ? 32 : 0;
        if (bx >= nkv) {
            const int gw2 = (bx - nkv) * 8 + wave, ngw2 = (G - nkv) * 8;
#pragma unroll 1
            for (int m = gw2; m < M; m += ngw2) {
                const GAS f32x4* xr = (const GAS f32x4*)(args.in[I_X] + (size_t)m * DM) + lane; GAS u32x2* o8 = (GAS u32x2*)(P_XN + (size_t)m * DM) + lane; float s = 0.f;
#pragma unroll
                for (int j = 0; j < 8; ++j) { const f32x4 v = xr[64 * j]; s += (v.x * v.x + v.y * v.y) + (v.z * v.z + v.w * v.w); u32x2 w; w.x = pk2(v.x, v.y); w.y = pk2(v.z, v.w); o8[64 * j] = w; }
                s = wave_sum(s); if (lane == 0) ((GAS u64*)P_RSS)[m] = (u64)(s * 1048576.0f + 0.5f);
            }
        }
    }
    GRID_BAR();
    {
        PHASE_VARS
#pragma unroll 1
        for (int rr = gw; rr < 4 * 512; rr += NGW) {
            const int layer = rr >> 9, b = (rr >> 8) & 1, m = rr & 255;
            const GAS bf16* kvrow = (const GAS bf16*)P_KVM + (size_t)rr * 1024;
            const int hm = lane >> 4, d0 = (lane & 15) * 8;
            const bf16x8 kv = *(const GAS bf16x8*)(kvrow + lane * 8); const bf16x8 vv = *(const GAS bf16x8*)(kvrow + 512 + lane * 8);
            float kf[8], ss = 0.f;
#pragma unroll
            for (int j = 0; j < 8; ++j) { kf[j] = bf2f((unsigned short)kv[j]); ss += kf[j] * kf[j]; }
            ss += __shfl_xor(ss, 1); ss += __shfl_xor(ss, 2); ss += __shfl_xor(ss, 4); ss += __shfl_xor(ss, 8);
            const float rk = 1.0f / sqrtf(ss * (1.0f / HD) + EPS);
            const GAS float* kg = (const GAS float*)args.in[I_XKN] + layer * HD + d0; const GAS float* qg = (const GAS float*)args.in[I_XQN] + layer * HD + d0;
            u32x4 w; unsigned wv[4];
#pragma unroll
            for (int j = 0; j < 4; ++j) wv[j] = pk2(kf[2 * j] * rk * kg[2 * j] * qg[2 * j], kf[2 * j + 1] * rk * kg[2 * j + 1] * qg[2 * j + 1]);
            w.x = wv[0]; w.y = wv[1]; w.z = wv[2]; w.w = wv[3];
            *(GAS u32x4*)((GAS bf16*)P_KN + ((size_t)((layer * 2 + b) * 4 + hm) * NMEM + m) * HD + d0) = w;
            GAS bf16* vt = (GAS bf16*)P_VTM + ((size_t)((layer * 2 + b) * 4 + hm) * HD + d0) * NMEM + m;
#pragma unroll
            for (int j = 0; j < 8; ++j) vt[(size_t)j * NMEM] = (bf16)vv[j];
        }
    }

#pragma unroll 1
    for (int layer = 0; layer < DEPTH; ++layer) {
        const int jj = layer >> 1; const bool is_sb = (layer & 1) == 0;
#pragma unroll 1
        for (int half = 0; half < 2; ++half) {
            const int cslot = 3 * layer + 2 * half;
            { PHASE_VARS
              pg8::DualSched S; S.t1.init(M, 2 * FFN); S.t2.init(0, 0); S.A1 = (const char*)P_XN; S.B1 = (const char*)((half ? P_WGU2 : P_WGU1) + (size_t)layer * 2 * FFN * DM); S.A2 = S.A1; S.B2 = S.B1;
              S.tstep = (size_t)256 * DM * 2; S.G = G; S.c = bx;
              pg8::EpiSwiGLU E{P_ACT, FFN, P_RSS + (size_t)cslot * M};
              pg8::gemm_phase<pg8::EpiSwiGLU, pg8::DualSched, true, true>(lds, DM, S, E, ptid); }
            GRID_BAR();
            { PHASE_VARS
              pg8::DualSched S; S.t1.init(M, DM); S.t2.init(0, 0); S.A1 = (const char*)P_ACT; S.B1 = (const char*)((half ? P_WDN2 : P_WDN1) + (size_t)layer * DM * FFN); S.A2 = S.A1; S.B2 = S.B1;
              S.tstep = (size_t)256 * FFN * 2; S.G = G; S.c = bx;
              const bool lastu = (layer == DEPTH - 1 && half == 1);
              pg8::EpiResid E{P_XN, DM, 0.5f, P_RSS + (size_t)(cslot + 1) * M, lastu ? out : nullptr};
              pg8::gemm_phase<pg8::EpiResid, pg8::DualSched, true, true>(lds, FFN, S, E, ptid); }
            GRID_BAR();
            if (half == 0) {
                { PHASE_VARS
                  pg8::DualSched S; S.tstep = (size_t)256 * DM * 2; S.G = G; S.c = bx;
                  pg8::EpiBf16 E{P_PROJ, is_sb ? PROJ_SB : PROJ_S5, P_VT, M, 0x7fffffff};
                  if (is_sb) { const bf16* W = P_WINSB + (size_t)jj * 5120 * DM; S.t1.init(M, PROJ_SB); S.t2.init(TOKW, M);
                      S.A1 = (const char*)P_XN; S.B1 = (const char*)W; S.A2 = (const char*)(W + (size_t)PROJ_SB * DM); S.B2 = (const char*)P_XN; }
                  else { S.t1.init(M, PROJ_S5); S.t2.init(0, 0); S.A1 = (const char*)P_XN; S.B1 = (const char*)(P_WINS5 + (size_t)jj * DM * DM); S.A2 = S.A1; S.B2 = S.B1; }
                  pg8::gemm_phase<pg8::EpiBf16, pg8::DualSched, true, true>(lds, DM, S, E, ptid); }
                GRID_BAR();
                if (is_sb) {
                    { PHASE_VARS
                      const bf16* KNl = P_KN + (size_t)layer * 2 * 4 * NMEM * HD; const bf16* VTMl = P_VTM + (size_t)layer * 2 * 4 * HD * NMEM;
                      constexpr int NSB = BATCH * SBH * (SEQ / 32);
#pragma unroll 1
                      for (int u = gw; u < NSB; u += NGW) { const int qt = u % (SEQ / 32), bh = u / (SEQ / 32); sb_attn_wave(P_PROJ, P_VT, P_TOK, P_RSS + (size_t)(cslot + 1) * M, bh / SBH, bh % SBH, qt, lane, lds + wave * 8704); }
                      cross_attn_phase(P_PROJ, PROJ_SB, 2 * TOKW, KNl, VTMl, P_TOK, P_RSS + (size_t)(cslot + 1) * M, lds, vcu, G, ptid, wave, lane); }
                    GRID_BAR();
                } else {
                    constexpr int NS5 = BATCH * S5G * S5NC, NCR = BATCH * MEMHEADS * (SEQ / 32);
                    { PHASE_VARS
                      const bf16* KNl = P_KN + (size_t)layer * 2 * 4 * NMEM * HD; const bf16* VTMl = P_VTM + (size_t)layer * 2 * 4 * HD * NMEM;
                      const bf16* Bb = P_BBAR + (size_t)jj * S5G * 128 * 16; const bf16* Cc = P_CCAT + (size_t)jj * S5G * 16 * 128; const float* Ab = P_ABAR + (size_t)jj * S5G * 64 * 4;
                      const float* dsk = args.in[I_S5D] + (size_t)jj * TOKW;
                      LAS unsigned char* wl = lds + wave * S5_LDS_WAVE;
#pragma unroll 1
                      for (int u = gw; u < NS5; u += NGW) { const int c = u / (BATCH * S5G), bg = u % (BATCH * S5G); s5_pass0_wave(P_PROJ, Bb, Ab, P_EB, P_RSS + (size_t)(cslot + 1) * M, bg / S5G, bg % S5G, c, wl, lane); }
                      cross_attn_phase(P_PROJ, PROJ_S5, TOKW, KNl, VTMl, P_TOK, P_RSS + (size_t)(cslot + 1) * M, lds, vcu, G, ptid, wave, lane); }
                    GRID_BAR();
                    { PHASE_VARS
                      const bf16* Bb = P_BBAR + (size_t)jj * S5G * 128 * 16; const bf16* Cc = P_CCAT + (size_t)jj * S5G * 16 * 128; const float* Ab = P_ABAR + (size_t)jj * S5G * 64 * 4;
                      const float* dsk = args.in[I_S5D] + (size_t)jj * TOKW;
                      LAS unsigned char* wl = lds + wave * S5_LDS_WAVE;
#pragma unroll 1
                      for (int u = gw; u < NS5; u += NGW) { const int c = u / (BATCH * S5G), bg = u % (BATCH * S5G); s5_wave<1>(P_PROJ, Bb, Cc, Ab, dsk, P_EB, P_YB, P_RSS + (size_t)(cslot + 1) * M, bg / S5G, bg % S5G, c, wl, lane); } }
                    GRID_BAR();
                    { PHASE_VARS
                      pg8::DualSched S; S.t1.init(M, TOKW); S.t2.init(0, 0); S.A1 = (const char*)P_YB; S.B1 = (const char*)(P_WGLU + (size_t)jj * TOKW * TOKW); S.A2 = S.A1; S.B2 = S.B1;
                      S.tstep = (size_t)256 * TOKW * 2; S.G = G; S.c = bx;
                      pg8::EpiGLU E{P_YB, TOKW, P_TOK, DM};
                      pg8::gemm_phase<pg8::EpiGLU, pg8::DualSched, true, true>(lds, TOKW, S, E, ptid); }
                    GRID_BAR();
                }
                { PHASE_VARS
                  pg8::DualSched S; S.t1.init(M, DM); S.t2.init(0, 0); S.A1 = (const char*)P_TOK; S.B1 = (const char*)(P_WOUT + (size_t)layer * DM * DM); S.A2 = S.A1; S.B2 = S.B1;
                  S.tstep = (size_t)256 * DM * 2; S.G = G; S.c = bx;
                  pg8::EpiResid E{P_XN, DM, 1.0f, P_RSS + (size_t)(cslot + 2) * M, nullptr};
                  pg8::gemm_phase<pg8::EpiResid, pg8::DualSched, true, true>(lds, DM, S, E, ptid); }
                GRID_BAR();
            }
        }
    }
}

extern "C" void kernel_launch(void* const* d_in, const int* in_sizes, int n_in, void* d_out, int out_size, void* d_ws, size_t ws_size, hipStream_t stream) {
    static int grid = 0;
    if (grid == 0) {
        if (n_in != 25 || in_sizes[0] != M * DM || out_size != M * DM || ws_size < WS_END) {
            fprintf(stderr, "kernel_launch: shape/workspace mismatch: n_in %d in0 %d out %d ws %zu (need %zu)\n", n_in, n_in > 0 ? in_sizes[0] : -1, out_size, ws_size, (size_t)WS_END); grid = -1; return; }
        int dev = 0, cus = 0, per_cu = 0;
        if (hipGetDevice(&dev) != hipSuccess || hipDeviceGetAttribute(&cus, hipDeviceAttributeMultiprocessorCount, dev) != hipSuccess) { fprintf(stderr, "kernel_launch: device query failed\n"); grid = -1; return; }
        if (hipFuncSetAttribute((const void*)fwd, hipFuncAttributeMaxDynamicSharedMemorySize, LDS_BYTES) != hipSuccess) { fprintf(stderr, "kernel_launch: hipFuncSetAttribute failed\n"); grid = -1; return; }
        if (hipOccupancyMaxActiveBlocksPerMultiprocessor(&per_cu, (const void*)fwd, 512, LDS_BYTES) != hipSuccess || per_cu < 1)
            fprintf(stderr, "kernel_launch: note: occupancy query reports %d workgroups per CU\n", per_cu);
        (void)hipGetLastError();
        grid = cus;
    }
    if (grid < 0) return;
    if (hipMemsetAsync((char*)d_ws + WS_CTL, 0, CTL_ZERO_BYTES, stream) != hipSuccess) { fprintf(stderr, "kernel_launch: memset failed\n"); return; }
    Args a{};
    for (int i = 0; i < 25; ++i) a.in[i] = (const float*)d_in[i];
    a.out = (float*)d_out; a.ws = (unsigned char*)d_ws;
    hipLaunchKernelGGL(fwd, dim3(grid), dim3(512), LDS_BYTES, stream, a);
    const hipError_t le = hipPeekAtLastError();
    if (le != hipSuccess) fprintf(stderr, "kernel_launch: launch failed: %s\n", hipGetErrorName(le));
}
```

```cpp
#include <hip/hip_runtime.h>
#include <cstdio>
#include <cstdint>

#define LAS __attribute__((address_space(3)))
#define GAS __attribute__((address_space(1)))
typedef unsigned short bf16;
typedef short bf16x8 __attribute__((ext_vector_type(8)));
typedef short bf16x4 __attribute__((ext_vector_type(4)));
typedef float f32x4 __attribute__((ext_vector_type(4)));
typedef float f32x2 __attribute__((ext_vector_type(2)));
typedef unsigned u32x4 __attribute__((ext_vector_type(4)));
typedef unsigned u32x2 __attribute__((ext_vector_type(2)));
typedef unsigned long long u64;
__device__ __forceinline__ float rss2f(u64 v) { return __builtin_fmaf((float)(unsigned)(v >> 32), 4096.0f, (float)(unsigned)v * (1.0f / 1048576.0f)); }

constexpr int BATCH = 2, SEQ = 8192, DM = 2048, DEPTH = 4, M = BATCH * SEQ;
constexpr int NMEM = 256, HD = 128, MEMW = 512, MEMHEADS = 4, TOKW = 1536, SBH = 12;
constexpr int FFN = 5632, S5G = 96, S5C = 16, S5N = 64;
constexpr int PROJ_SB = 3584;
constexpr int PROJ_S5 = 2048;
constexpr int S5T = 256, S5NC = SEQ / S5T, S5T_LOG2 = 8;
constexpr float EPS = 1e-6f;

constexpr size_t MiB = 1u << 20;
constexpr size_t WS_CTL = 0, CTL_ZERO_BYTES = 3 * MiB;
constexpr size_t WS_RSS = 1 * MiB;
constexpr size_t SZ_GU = (size_t)2 * FFN * DM * 2, SZ_DN = (size_t)DM * FFN * 2, SZ_OUT = (size_t)DM * DM * 2, SZ_KV = (size_t)1024 * DM * 2;
constexpr size_t SZ_INSB = (size_t)5120 * DM * 2, SZ_INS5 = (size_t)DM * DM * 2, SZ_GLU = (size_t)TOKW * TOKW * 2;
constexpr size_t WS_WGU1 = 3 * MiB;
constexpr size_t WS_WDN1 = WS_WGU1 + 4 * SZ_GU;
constexpr size_t WS_WGU2 = WS_WDN1 + 4 * SZ_DN;
constexpr size_t WS_WDN2 = WS_WGU2 + 4 * SZ_GU;
constexpr size_t WS_WOUT = WS_WDN2 + 4 * SZ_DN;
constexpr size_t WS_WKV = WS_WOUT + 4 * SZ_OUT;
constexpr size_t WS_WINSB = WS_WKV + 4 * SZ_KV;
constexpr size_t WS_WINS5 = WS_WINSB + 2 * SZ_INSB;
constexpr size_t WS_WGLU = WS_WINS5 + 2 * SZ_INS5;
constexpr size_t WS_XN = WS_WGLU + 2 * SZ_GLU;
constexpr size_t WS_ACT = WS_XN + (size_t)M * DM * 2;
constexpr size_t WS_PROJ = WS_ACT + (size_t)M * FFN * 2;
constexpr size_t WS_VT = WS_PROJ + (size_t)M * PROJ_SB * 2;
constexpr size_t WS_TOK = WS_VT + (size_t)TOKW * M * 2;
constexpr size_t WS_MEMH = WS_TOK + (size_t)M * DM * 2;
constexpr size_t WS_KVM = WS_MEMH + (size_t)4 * 512 * DM * 2;
constexpr size_t WS_KN = WS_KVM + (size_t)4 * 512 * 1024 * 2;
constexpr size_t WS_VTM = WS_KN + (size_t)4 * 2 * 4 * 256 * 128 * 2;
constexpr size_t WS_BBAR = WS_VTM + (size_t)4 * 2 * 4 * 256 * 128 * 2;
constexpr size_t WS_CCAT = WS_BBAR + (size_t)2 * 96 * 128 * 16 * 2;
constexpr size_t WS_ABAR = WS_CCAT + (size_t)2 * 96 * 16 * 128 * 2;
constexpr size_t WS_E = WS_ABAR + (size_t)2 * 96 * 64 * 16;
constexpr size_t WS_END = WS_E + (size_t)2 * 96 * S5NC * 64 * 8;
constexpr int CW_BAR = 4096;

constexpr int RING_BYTES = 131072;
constexpr int LDS_BYTES = 163840;
constexpr int LDSCTL_OFF = LDS_BYTES - 512, MISC_OFF = LDSCTL_OFF + 320;
constexpr int XK_ROWB = 256 + 16, XV_ROWB = 512 + 16, XV_OFF = 256 * XK_ROWB, X_STAGE_BYTES = XV_OFF + 128 * XV_ROWB;
static_assert(X_STAGE_BYTES <= LDSCTL_OFF, "cross-attention K/V image fits under the LDS control words");

namespace pg8 {
constexpr int BM = 256, BK = 64, HALF = 128, HTB = HALF * BK * 2, STAGE_BYTES = 8 * HTB, NXCD = 8, WGM = 8;
__host__ __device__ __forceinline__ int lds_byte(int r, int c) { const int st = (r >> 4) * 2 + (c >> 5), rr = r & 15, cc = c & 31, ob = rr * 64 + cc * 2; return st * 1024 + (ob ^ (((ob >> 9) & 1) << 5)); }
__host__ __device__ __forceinline__ void stage_rc(int b, int& R, int& C) { const int st = b / 1024, sb = b % 1024, swz = sb ^ (((sb >> 9) & 1) << 5); R = (st >> 1) * 16 + swz / 64; C = (st & 1) * 32 + (swz % 64) / 2; }
__host__ __device__ __forceinline__ int perm32(int rho) { const int n = rho >> 4, i = rho & 15; return 8 * (i >> 2) + 4 * n + (i & 3); }

struct Unit { int pm, pn, sel; };
struct TileOrder {
    int nM, nN, nwg;
    __device__ __forceinline__ void init(int Mr, int Nc) { nM = Mr / BM; nN = Nc / BM; nwg = nM * nN; }
    __device__ __forceinline__ void map(int L, int& pm, int& pn) const {
        int wgid = L; { const int q = nwg / NXCD, r = nwg % NXCD, xcd = wgid % NXCD, off = wgid / NXCD; wgid = (xcd < r ? xcd * (q + 1) : r * (q + 1) + (xcd - r) * q) + off; }
        const int nig = WGM * nN, gid = wgid / nig, fm = gid * WGM, gsz = (nM - fm) < WGM ? (nM - fm) : WGM;
        pm = fm + ((wgid % nig) % gsz); pn = (wgid % nig) / gsz;
    }
};
struct DualSched {
    TileOrder t1, t2; const char *A1, *B1, *A2, *B2; size_t tstep; int G, c;
    __device__ __forceinline__ bool next(int i, Unit& u) const {
        const int L = i * G + c;
        if (L < t1.nwg) { t1.map(L, u.pm, u.pn); u.sel = 0; return true; }
        if (L < t1.nwg + t2.nwg) { t2.map(L - t1.nwg, u.pm, u.pn); u.sel = 1; return true; }
        return false;
    }
    __device__ __forceinline__ const char* a_ptr(const Unit& u) const { return (u.sel ? A2 : A1) + (size_t)u.pm * tstep; }
    __device__ __forceinline__ const char* b_ptr(const Unit& u) const { return (u.sel ? B2 : B1) + (size_t)u.pn * tstep; }
};
struct KvSched {
    const char *A, *B; size_t tstep; int G, c;
    __device__ __forceinline__ bool next(int i, Unit& u) const { const int L = i * G + c; if (L >= 32) return false; const int layer = L >> 3; u.pm = 2 * layer + (L & 1); u.pn = 4 * layer + ((L >> 1) & 3); u.sel = 0; return true; }
    __device__ __forceinline__ const char* a_ptr(const Unit& u) const { return A + (size_t)u.pm * tstep; }
    __device__ __forceinline__ const char* b_ptr(const Unit& u) const { return B + (size_t)u.pn * tstep; }
};

__device__ __forceinline__ unsigned cvt_pk_bf16(float lo, float hi) { unsigned r; asm volatile("v_cvt_pk_bf16_f32 %0, %1, %2" : "=v"(r) : "v"(lo), "v"(hi)); return r; }
__device__ __forceinline__ float fexp(float x) { return __builtin_amdgcn_exp2f(x * 1.4426950408889634f); }
__device__ __forceinline__ float flog(float x) { return __builtin_amdgcn_logf(x) * 0.6931471805599453f; }
__device__ __forceinline__ float fsigmoid(float x) { return __builtin_amdgcn_rcpf(1.0f + fexp(-x)); }

struct EpiSwiGLU {
    static constexpr bool PERM = true;
    struct Pre { u64 rs[8]; };
    bf16* O; int ldc; const u64* rss;
    __device__ __forceinline__ void prefetch(Pre& p, const Unit& u, int wr, int fr) const {
        const GAS u64* r = (const GAS u64*)rss + u.pm * BM + wr * 64 + fr;
#pragma unroll
        for (int ai = 0; ai < 2; ++ai)
#pragma unroll
            for (int m = 0; m < 4; ++m) p.rs[ai * 4 + m] = r[ai * HALF + m * 16];
    }
    __device__ __forceinline__ void operator()(const f32x4 (&acc)[2][2][4][2], const Unit& u, const Pre& p, int wr, int wc, int fr, int fq) const {
        const int row0 = u.pm * BM + wr * 64 + fr, col0 = u.pn * HALF + wc * 32 + 8 * fq;
#pragma unroll
        for (int ai = 0; ai < 2; ++ai)
#pragma unroll
            for (int m = 0; m < 4; ++m) {
                GAS bf16* rowp = (GAS bf16*)O + (size_t)(row0 + ai * HALF + m * 16) * ldc + col0;
                const float rr = __builtin_amdgcn_rsqf(rss2f(p.rs[ai * 4 + m]) * (1.0f / DM) + EPS);
                const float nl = -1.4426950408889634f * rr, rr2 = rr * rr;
                f32x2 t2[4], gu[4], o2[4];
#pragma unroll
                for (int q = 0; q < 4; ++q) { const f32x2 ag = (f32x2){acc[ai][0][m][q >> 1][2 * (q & 1)], acc[ai][0][m][q >> 1][2 * (q & 1) + 1]}, au = (f32x2){acc[ai][1][m][q >> 1][2 * (q & 1)], acc[ai][1][m][q >> 1][2 * (q & 1) + 1]};
                    t2[q] = ag * nl; gu[q] = (ag * au) * rr2; }
#pragma unroll
                for (int q = 0; q < 4; ++q) { t2[q].x = __builtin_amdgcn_exp2f(t2[q].x); t2[q].y = __builtin_amdgcn_exp2f(t2[q].y); }
#pragma unroll
                for (int q = 0; q < 4; ++q) { t2[q] = t2[q] + 1.0f; }
#pragma unroll
                for (int q = 0; q < 4; ++q) { t2[q].x = __builtin_amdgcn_rcpf(t2[q].x); t2[q].y = __builtin_amdgcn_rcpf(t2[q].y); }
#pragma unroll
                for (int q = 0; q < 4; ++q) o2[q] = gu[q] * t2[q];
                u32x4 w; w.x = cvt_pk_bf16(o2[0].x, o2[0].y); w.y = cvt_pk_bf16(o2[1].x, o2[1].y); w.z = cvt_pk_bf16(o2[2].x, o2[2].y); w.w = cvt_pk_bf16(o2[3].x, o2[3].y);
                *(GAS u32x4*)rowp = w;
            }
    }
};
struct EpiResid {
    static constexpr bool PERM = true;
    struct Pre {};
    bf16* xb; int ldc; float scale; u64* rss; float* outf;
    __device__ __forceinline__ void prefetch(Pre&, const Unit&, int, int) const {}
    __device__ __forceinline__ void operator()(const f32x4 (&acc)[2][2][4][2], const Unit& u, const Pre&, int wr, int wc, int fr, int fq) const {
        const int row0 = u.pm * BM + wr * 64 + fr, col0 = u.pn * BM + wc * 32 + 8 * fq;
#pragma unroll
        for (int ai = 0; ai < 2; ++ai) {
            u32x4 bs[4][2];
#pragma unroll
            for (int m = 0; m < 4; ++m)
#pragma unroll
                for (int bj = 0; bj < 2; ++bj) bs[m][bj] = *(const GAS u32x4*)((const GAS bf16*)xb + (size_t)(row0 + ai * HALF + m * 16) * ldc + col0 + bj * HALF);
#pragma unroll
            for (int m = 0; m < 4; ++m) { const size_t off = (size_t)(row0 + ai * HALF + m * 16) * ldc + col0; float s = 0.f;
#pragma unroll
                for (int bj = 0; bj < 2; ++bj) { f32x2 v2[4];
#pragma unroll
                    for (int j = 0; j < 4; ++j) { const unsigned w = bs[m][bj][j]; const f32x2 xx = (f32x2){__uint_as_float(w << 16), __uint_as_float(w & 0xffff0000u)};
                        const f32x2 aa = (j < 2) ? (f32x2){acc[ai][bj][m][0][2 * j], acc[ai][bj][m][0][2 * j + 1]} : (f32x2){acc[ai][bj][m][1][2 * j - 4], acc[ai][bj][m][1][2 * j - 3]};
                        v2[j] = aa * scale + xx; }
                    if (outf) { *(GAS f32x4*)((GAS float*)outf + off + bj * HALF) = (f32x4){v2[0].x, v2[0].y, v2[1].x, v2[1].y}; *(GAS f32x4*)((GAS float*)outf + off + bj * HALF + 4) = (f32x4){v2[2].x, v2[2].y, v2[3].x, v2[3].y}; }
                    else { u32x4 w; w.x = cvt_pk_bf16(v2[0].x, v2[0].y); w.y = cvt_pk_bf16(v2[1].x, v2[1].y); w.z = cvt_pk_bf16(v2[2].x, v2[2].y); w.w = cvt_pk_bf16(v2[3].x, v2[3].y);
                        *(GAS u32x4*)((GAS bf16*)xb + off + bj * HALF) = w;
                        const f32x2 q2 = (v2[0] * v2[0] + v2[1] * v2[1]) + (v2[2] * v2[2] + v2[3] * v2[3]);
                        s += q2.x + q2.y; } }
                if (!outf) { s += __shfl_xor(s, 16); s += __shfl_xor(s, 32);
                    if (fq == 0) (void)__hip_atomic_fetch_add((GAS u64*)rss + row0 + ai * HALF + m * 16, (u64)(s * 1048576.0f + 0.5f), __ATOMIC_RELAXED, __HIP_MEMORY_SCOPE_AGENT); } }
            asm volatile("" ::: "memory");
        }
    }
};
struct EpiBf16 {
    static constexpr bool PERM = true;
    struct Pre {};
    bf16* O0; int ldc0; bf16* O1; int ldc1; int pn_mask;
    __device__ __forceinline__ void prefetch(Pre&, const Unit&, int, int) const {}
    __device__ __forceinline__ void operator()(const f32x4 (&acc)[2][2][4][2], const Unit& u, const Pre&, int wr, int wc, int fr, int fq) const {
        bf16* O = u.sel ? O1 : O0; const int ldc = u.sel ? ldc1 : ldc0;
        const int row0 = u.pm * BM + wr * 64 + fr, col0 = (u.pn & pn_mask) * BM + wc * 32 + 8 * fq;
#pragma unroll
        for (int ai = 0; ai < 2; ++ai)
#pragma unroll
            for (int m = 0; m < 4; ++m) {
                GAS bf16* rowp = (GAS bf16*)O + (size_t)(row0 + ai * HALF + m * 16) * ldc + col0;
#pragma unroll
                for (int bj = 0; bj < 2; ++bj) { const f32x4 v0 = acc[ai][bj][m][0], v1 = acc[ai][bj][m][1];
                    u32x4 w; w.x = cvt_pk_bf16(v0[0], v0[1]); w.y = cvt_pk_bf16(v0[2], v0[3]); w.z = cvt_pk_bf16(v1[0], v1[1]); w.w = cvt_pk_bf16(v1[2], v1[3]);
                    *(GAS u32x4*)(rowp + bj * HALF) = w; }
            }
    }
};
struct EpiGLU {
    static constexpr bool PERM = true;
    struct Pre {};
    const bf16* Y; int ldy; bf16* O; int ldc;
    __device__ __forceinline__ void prefetch(Pre&, const Unit&, int, int) const {}
    __device__ __forceinline__ void operator()(const f32x4 (&acc)[2][2][4][2], const Unit& u, const Pre&, int wr, int wc, int fr, int fq) const {
        const int row0 = u.pm * BM + wr * 64 + fr, col0 = u.pn * BM + wc * 32 + 8 * fq;
#pragma unroll
        for (int ai = 0; ai < 2; ++ai)
#pragma unroll
            for (int m = 0; m < 4; ++m) {
                const size_t r = (size_t)(row0 + ai * HALF + m * 16);
#pragma unroll
                for (int bj = 0; bj < 2; ++bj) {
                    const u32x4 yv = *(const GAS u32x4*)((const GAS bf16*)Y + r * ldy + col0 + bj * HALF);
                    const f32x4 v0 = acc[ai][bj][m][0], v1 = acc[ai][bj][m][1];
                    f32x2 t2[4], o2[4];
#pragma unroll
                    for (int j = 0; j < 4; ++j) { const f32x2 aa = (j < 2) ? (f32x2){v0[2 * j], v0[2 * j + 1]} : (f32x2){v1[2 * j - 4], v1[2 * j - 3]}; t2[j] = aa * -1.4426950408889634f; }
#pragma unroll
                    for (int j = 0; j < 4; ++j) { t2[j].x = __builtin_amdgcn_exp2f(t2[j].x); t2[j].y = __builtin_amdgcn_exp2f(t2[j].y); }
#pragma unroll
                    for (int j = 0; j < 4; ++j) t2[j] = t2[j] + 1.0f;
#pragma unroll
                    for (int j = 0; j < 4; ++j) { t2[j].x = __builtin_amdgcn_rcpf(t2[j].x); t2[j].y = __builtin_amdgcn_rcpf(t2[j].y); }
#pragma unroll
                    for (int j = 0; j < 4; ++j) { const unsigned yw = yv[j]; o2[j] = (f32x2){__uint_as_float(yw << 16), __uint_as_float(yw & 0xffff0000u)} * t2[j]; }
                    u32x4 w; w.x = cvt_pk_bf16(o2[0].x, o2[0].y); w.y = cvt_pk_bf16(o2[1].x, o2[1].y); w.z = cvt_pk_bf16(o2[2].x, o2[2].y); w.w = cvt_pk_bf16(o2[3].x, o2[3].y);
                    *(GAS u32x4*)((GAS bf16*)O + r * ldc + col0 + bj * HALF) = w;
                }
            }
    }
};

template <class Epi, class Sched, bool ALIGN_EPI, bool SP2>
__device__ __forceinline__ void gemm_phase(LAS unsigned char* lds, const int K, const Sched& S, const Epi& E, const int tid) {
    const int wid = __builtin_amdgcn_readfirstlane(tid >> 6), lane = tid & 63, wr = wid >> 2, wc = wid & 3, fr = lane & 15, fq = lane >> 4;
    const int nt = K / BK;
    unsigned voffA[2], voffB[2];
#pragma unroll
    for (int i = 0; i < 2; ++i) { int R, C; stage_rc(tid * 16 + i * 8192, R, C); const int Rb = Epi::PERM ? ((R & ~31) + perm32(R & 31)) : R;
        voffA[i] = (unsigned)(R * K + C) * 2u; voffB[i] = (unsigned)(Rb * K + C) * 2u; }
    const size_t kstep = (size_t)(BK * 2);
    const size_t hstep = (size_t)HALF * K * 2;
    const unsigned ldsw = (unsigned)wid * 1024u;
    const int aoff = lds_byte(wr * 64 + fr, fq * 8), boff = lds_byte(wc * 32 + fr, fq * 8);
#define PG8_SA(b, h) (((b) * 2 + (h)) * HTB)
#define PG8_SB(b, h) ((4 + (b) * 2 + (h)) * HTB)
#define PG8_STAGE(bufoff, gbase, voff) do { _Pragma("unroll") for (int _i = 0; _i < 2; ++_i) \
        __builtin_amdgcn_global_load_lds((const unsigned*)((const char*)(gbase) + (voff)[_i]), (LAS unsigned*)(lds + (bufoff) + ldsw + _i * 8192), 16, 0, 0); } while (0)
#define PG8_LDA(dst, b, h) do { _Pragma("unroll") for (int m = 0; m < 4; ++m) _Pragma("unroll") for (int k = 0; k < 2; ++k) dst[m][k] = *(const LAS bf16x8*)(lds + PG8_SA(b, h) + aoff + m * 2048 + k * 1024); } while (0)
#define PG8_LDB(dst, b, h) do { _Pragma("unroll") for (int n = 0; n < 2; ++n) _Pragma("unroll") for (int k = 0; k < 2; ++k) dst[n][k] = *(const LAS bf16x8*)(lds + PG8_SB(b, h) + boff + n * 2048 + k * 1024); } while (0)
#define PG8_MMA(ai, bj, At, Bt) do { __builtin_amdgcn_s_setprio(1); _Pragma("unroll") for (int m = 0; m < 4; ++m) _Pragma("unroll") for (int n = 0; n < 2; ++n) _Pragma("unroll") for (int k = 0; k < 2; ++k) \
        acc[ai][bj][m][n] = __builtin_amdgcn_mfma_f32_16x16x32_bf16(Bt[n][k], At[m][k], acc[ai][bj][m][n], 0, 0, 0); __builtin_amdgcn_s_setprio(0); } while (0)
#define PG8_WAIT_V(n) asm volatile("s_waitcnt vmcnt(" #n ")" ::: "memory")
#define PG8_WAIT_L(n) asm volatile("s_waitcnt lgkmcnt(" #n ")" ::: "memory")
#define PG8_BAR __builtin_amdgcn_s_barrier()
#define PG8_SCHED __builtin_amdgcn_sched_barrier(0)
    Unit cur, nxt; int ui = 0;
    if (!S.next(0, cur)) return;
    f32x4 acc[2][2][4][2];
#pragma unroll
    for (int a = 0; a < 2; ++a)
#pragma unroll
        for (int b = 0; b < 2; ++b)
#pragma unroll
            for (int m = 0; m < 4; ++m)
#pragma unroll
                for (int n = 0; n < 2; ++n) acc[a][b][m][n] = (f32x4){0.f, 0.f, 0.f, 0.f};
    bf16x8 At[4][2], B0[2][2], B1[2][2];
    const char* cA = S.a_ptr(cur); const char* cB = S.b_ptr(cur);
    typename Epi::Pre pre; E.prefetch(pre, cur, wr, fr);
    if constexpr (SP2) {
        PG8_STAGE(PG8_SB(0, 0), cB, voffB); PG8_STAGE(PG8_SB(0, 1), cB + hstep, voffB); PG8_STAGE(PG8_SA(0, 0), cA, voffA); PG8_STAGE(PG8_SA(0, 1), cA + hstep, voffA);
        if (wr == 1) PG8_BAR;
        PG8_WAIT_V(2); PG8_BAR;
        PG8_STAGE(PG8_SB(1, 0), cB + kstep, voffB); PG8_STAGE(PG8_SA(1, 0), cA + kstep, voffA); PG8_STAGE(PG8_SB(1, 1), cB + hstep + kstep, voffB);
        PG8_WAIT_V(6); PG8_BAR;
    } else {
        PG8_STAGE(PG8_SB(0, 0), cB, voffB); PG8_STAGE(PG8_SA(0, 0), cA, voffA); PG8_STAGE(PG8_SB(0, 1), cB + hstep, voffB); PG8_STAGE(PG8_SA(0, 1), cA + hstep, voffA);
        if (wr == 1) PG8_BAR;
        PG8_WAIT_V(4); PG8_BAR;
        PG8_STAGE(PG8_SB(1, 0), cB + kstep, voffB); PG8_STAGE(PG8_SA(1, 0), cA + kstep, voffA); PG8_STAGE(PG8_SB(1, 1), cB + hstep + kstep, voffB);
        PG8_WAIT_V(6); PG8_BAR;
    }
    for (;;) {
        const bool has_next = S.next(ui + 1, nxt);
        const char* nA = has_next ? S.a_ptr(nxt) : cA; const char* nB = has_next ? S.b_ptr(nxt) : cB;
        for (int t = 0; t < nt; t += 2) {
            const bool last = (t == nt - 2);
            const char* a1 = cA + (size_t)(t + 1) * kstep;
            const char* a2 = last ? nA : cA + (size_t)(t + 2) * kstep; const char* b2 = last ? nB : cB + (size_t)(t + 2) * kstep;
            const char* a3 = a2 + kstep; const char* b3 = b2 + kstep;
            if constexpr (SP2) {
            PG8_LDB(B0, 0, 0); PG8_LDB(B1, 0, 1); PG8_SCHED; PG8_LDA(At, 0, 0); PG8_STAGE(PG8_SA(1, 1), a1 + hstep, voffA);
            PG8_WAIT_V(8); PG8_WAIT_L(0); PG8_BAR; PG8_MMA(0, 0, At, B0); PG8_MMA(0, 1, At, B1); PG8_BAR; PG8_SCHED;
            PG8_LDA(At, 0, 1); PG8_STAGE(PG8_SB(0, 0), b2, voffB); PG8_STAGE(PG8_SB(0, 1), b2 + hstep, voffB); PG8_STAGE(PG8_SA(0, 0), a2, voffA);
            PG8_WAIT_V(8); PG8_WAIT_L(0); PG8_BAR; PG8_MMA(1, 0, At, B0); PG8_MMA(1, 1, At, B1); PG8_BAR; PG8_SCHED;
            PG8_LDB(B0, 1, 0); PG8_LDB(B1, 1, 1); PG8_SCHED; PG8_LDA(At, 1, 0); PG8_STAGE(PG8_SA(0, 1), a2 + hstep, voffA);
            PG8_WAIT_V(8); PG8_WAIT_L(0); PG8_BAR; PG8_MMA(0, 0, At, B0); PG8_MMA(0, 1, At, B1); PG8_BAR; PG8_SCHED;
            PG8_LDA(At, 1, 1); PG8_STAGE(PG8_SB(1, 0), b3, voffB); PG8_STAGE(PG8_SB(1, 1), b3 + hstep, voffB); PG8_STAGE(PG8_SA(1, 0), a3, voffA);
            PG8_WAIT_V(8); PG8_WAIT_L(0); PG8_BAR; PG8_MMA(1, 0, At, B0); PG8_MMA(1, 1, At, B1); PG8_BAR; PG8_SCHED;
            } else {
            PG8_LDB(B0, 0, 0); PG8_SCHED; PG8_LDA(At, 0, 0); PG8_STAGE(PG8_SA(1, 1), a1 + hstep, voffA);
            PG8_WAIT_L(8); PG8_BAR; PG8_WAIT_L(0); PG8_MMA(0, 0, At, B0); PG8_BAR; PG8_SCHED;
            PG8_LDB(B1, 0, 1); PG8_STAGE(PG8_SB(0, 0), b2, voffB);
            PG8_BAR; PG8_WAIT_L(0); PG8_MMA(0, 1, At, B1); PG8_BAR;
            PG8_LDA(At, 0, 1); PG8_STAGE(PG8_SA(0, 0), a2, voffA);
            PG8_BAR; PG8_WAIT_L(0); PG8_MMA(1, 0, At, B0); PG8_BAR; PG8_SCHED;
            PG8_STAGE(PG8_SB(0, 1), b2 + hstep, voffB);
            PG8_WAIT_V(6); PG8_BAR; PG8_MMA(1, 1, At, B1); PG8_BAR;
            PG8_LDB(B0, 1, 0); PG8_SCHED; PG8_LDA(At, 1, 0); PG8_STAGE(PG8_SA(0, 1), a2 + hstep, voffA);
            PG8_WAIT_L(8); PG8_BAR; PG8_WAIT_L(0); PG8_MMA(0, 0, At, B0); PG8_BAR; PG8_SCHED;
            PG8_LDB(B1, 1, 1); PG8_STAGE(PG8_SB(1, 0), b3, voffB);
            PG8_BAR; PG8_WAIT_L(0); PG8_MMA(0, 1, At, B1); PG8_BAR;
            PG8_LDA(At, 1, 1); PG8_STAGE(PG8_SA(1, 0), a3, voffA);
            PG8_BAR; PG8_WAIT_L(0); PG8_MMA(1, 0, At, B0); PG8_BAR; PG8_SCHED;
            PG8_STAGE(PG8_SB(1, 1), b3 + hstep, voffB);
            PG8_WAIT_V(6); PG8_BAR; PG8_MMA(1, 1, At, B1); PG8_BAR;
            }
        }
        if constexpr (ALIGN_EPI) { if (wr == 0) PG8_BAR; }
        E(acc, cur, pre, wr, wc, fr, fq);
        if (!has_next) break;
#pragma unroll
        for (int a = 0; a < 2; ++a)
#pragma unroll
            for (int b = 0; b < 2; ++b)
#pragma unroll
                for (int m = 0; m < 4; ++m)
#pragma unroll
                    for (int n = 0; n < 2; ++n) acc[a][b][m][n] = (f32x4){0.f, 0.f, 0.f, 0.f};
        cur = nxt; cA = nA; cB = nB; ++ui;
        E.prefetch(pre, cur, wr, fr);
        if constexpr (ALIGN_EPI) { if (wr == 1) PG8_BAR; }
    }
    PG8_WAIT_V(0);
    if constexpr (!ALIGN_EPI) { if (wr == 0) PG8_BAR; }
    PG8_BAR;
#undef PG8_SA
#undef PG8_SB
#undef PG8_STAGE
#undef PG8_LDA
#undef PG8_LDB
#undef PG8_MMA
#undef PG8_WAIT_V
#undef PG8_WAIT_L
#undef PG8_BAR
#undef PG8_SCHED
}
}

typedef GAS unsigned gu32;
#define RLX_AGENT __ATOMIC_RELAXED, __HIP_MEMORY_SCOPE_AGENT
#define LDS_WAIT() asm volatile("s_waitcnt lgkmcnt(0)" ::: "memory")
#define VM_WAIT() asm volatile("s_waitcnt vmcnt(0)" ::: "memory")
__device__ __forceinline__ unsigned f2bf(float f) { unsigned u = __builtin_bit_cast(unsigned, f); return (u + 0x7fffu + ((u >> 16) & 1u)) >> 16; }
__device__ __forceinline__ unsigned pk2(float lo, float hi) { return pg8::cvt_pk_bf16(lo, hi); }
__device__ __forceinline__ float bf2f(unsigned short b) { return __uint_as_float(((unsigned)b) << 16); }
__device__ __forceinline__ f32x4 mfma16(bf16x8 a, bf16x8 b, f32x4 c) { return __builtin_amdgcn_mfma_f32_16x16x32_bf16(a, b, c, 0, 0, 0); }
using pg8::cvt_pk_bf16; using pg8::fexp; using pg8::flog; using pg8::fsigmoid;

#define XB_TMO      128
#define XB_XCNT(j)  (256  + 64 * (j))
#define XB_XSUB(j)  (1280 + 64 * (j))
#define XB_XGEN(j)  (2304 + 64 * (j))
#define XB_TOP      3328
#define XB_TOPGEN   3392
#define XCD_BAR_WORDS 3456
#define XB_SPIN_CAP (1u << 21)
__device__ __forceinline__ unsigned xb_ld(unsigned* p)              { return __hip_atomic_load(p, __ATOMIC_RELAXED, __HIP_MEMORY_SCOPE_AGENT); }
__device__ __forceinline__ unsigned xb_add(unsigned* p, unsigned v) { return __hip_atomic_fetch_add(p, v, __ATOMIC_RELAXED, __HIP_MEMORY_SCOPE_AGENT); }
__device__ __forceinline__ unsigned xb_xcc_id() { return (unsigned)__builtin_amdgcn_s_getreg((3 << 11) | 20) & 0xFu; }
#define XB_SPIN(cond, bar) do { unsigned _sp = 0; while (cond) { __builtin_amdgcn_s_sleep(1); \
    if ((++_sp & 255u) == 0u) { if (xb_ld(&(bar)[XB_TMO])) break; if (_sp > XB_SPIN_CAP) { atomicAdd(&(bar)[XB_TMO], 1u); break; } } } } while (0)
struct XcdBarrier { unsigned* bar; unsigned x; volatile LAS unsigned* st; };
__device__ __forceinline__ XcdBarrier xcd_barrier_post(unsigned* bar, volatile LAS unsigned* st) {
    XcdBarrier b; b.bar = bar; b.x = xb_xcc_id(); b.st = st;
    if (threadIdx.x == 0) (void)xb_add(&bar[XB_XCNT(b.x)], 1u);
    return b;
}
__device__ __forceinline__ void xcd_barrier_complete(unsigned* bar, unsigned x, unsigned& nloc, unsigned& nx) {
    const unsigned G = gridDim.x * gridDim.y * gridDim.z;
    unsigned sum, cnt, mine, sp = 0u;
    for (;;) {
        sum = 0u; cnt = 0u; mine = 0u;
#pragma unroll
        for (unsigned j = 0; j < 16; ++j) { const unsigned c = xb_ld(&bar[XB_XCNT(j)]); sum += c; cnt += (c > 0u) ? 1u : 0u; mine = (j == x) ? c : mine; }
        if (sum == G) break;
        __builtin_amdgcn_s_sleep(1);
        if ((++sp & 255u) == 0u) { if (xb_ld(&bar[XB_TMO])) break; if (sp > XB_SPIN_CAP) { atomicAdd(&bar[XB_TMO], 1u); break; } }
    }
    nloc = mine > 0u ? mine : 1u; nx = cnt > 0u ? cnt : 1u;
}
__device__ __forceinline__ void xcd_barrier(const XcdBarrier& b) {
    asm volatile("s_waitcnt vmcnt(0)" ::: "memory");
    __syncthreads();
    if (threadIdx.x == 0) {
        unsigned* bar = b.bar;
        __builtin_amdgcn_s_waitcnt(0);
        unsigned nloc = b.st[0], nx = b.st[1];
        if (nloc == 0u) { xcd_barrier_complete(bar, b.x, nloc, nx); b.st[0] = nloc; b.st[1] = nx; }
        const unsigned old = xb_add(&bar[XB_XSUB(b.x)], 1u);
        const unsigned gen = old / nloc;
        if (old + 1u == (gen + 1u) * nloc) {
            __builtin_amdgcn_fence(__ATOMIC_RELEASE, "agent");
            asm volatile("s_waitcnt vmcnt(0)" ::: "memory");
            const unsigned og = xb_add(&bar[XB_TOP], 1u);
            const unsigned tg = og / nx;
            if (og + 1u == (tg + 1u) * nx) xb_add(&bar[XB_TOPGEN], 1u);
            else XB_SPIN(xb_ld(&bar[XB_TOPGEN]) == tg, bar);
            __builtin_amdgcn_fence(__ATOMIC_ACQUIRE, "agent");
            xb_add(&bar[XB_XGEN(b.x)], 1u);
            asm volatile("s_waitcnt vmcnt(0)" ::: "memory");
        } else {
            XB_SPIN(xb_ld(&bar[XB_XGEN(b.x)]) == gen, bar);
            __builtin_amdgcn_fence(__ATOMIC_ACQUIRE, "agent");
            asm volatile("s_waitcnt vmcnt(0)" ::: "memory");
        }
    }
    __syncthreads();
}

__device__ __forceinline__ float wave_sum(float v) {
#pragma unroll
    for (int o = 1; o < 64; o <<= 1) v += __shfl_xor(v, o);
    return v;
}
__device__ __forceinline__ void transpose_item(const float* W, int K, int N, bf16* WT, int k0, int n0, int drow0, LAS float* scr, int lane, const float* gain = nullptr) {
    const int c = lane & 7, rq = lane >> 3;
    const GAS float* src = (const GAS float*)W + (size_t)(k0 + rq) * N + n0 + 4 * c;
    f32x4 v[8];
#pragma unroll
    for (int i = 0; i < 8; ++i) v[i] = *(const GAS f32x4*)(src + (size_t)(8 * i) * N);
    f32x4 g0 = (f32x4){1.f, 1.f, 1.f, 1.f}, g1 = g0;
    if (gain) { g0 = *(const GAS f32x4*)((const GAS float*)gain + k0 + 8 * c); g1 = *(const GAS f32x4*)((const GAS float*)gain + k0 + 8 * c + 4); }
#pragma unroll
    for (int i = 0; i < 8; ++i) { LAS float* d = scr + (8 * i + rq) * 33 + 4 * c; d[0] = v[i].x; d[1] = v[i].y; d[2] = v[i].z; d[3] = v[i].w; }
    LDS_WAIT(); asm volatile("" ::: "memory");
#pragma unroll
    for (int j = 0; j < 4; ++j) { const int n = rq + 8 * j; const LAS float* s = scr + (8 * c) * 33 + n;
        u32x4 o; o.x = pk2(s[0 * 33] * g0.x, s[1 * 33] * g0.y); o.y = pk2(s[2 * 33] * g0.z, s[3 * 33] * g0.w); o.z = pk2(s[4 * 33] * g1.x, s[5 * 33] * g1.y); o.w = pk2(s[6 * 33] * g1.z, s[7 * 33] * g1.w);
        *(GAS u32x4*)(WT + (size_t)(drow0 + n) * K + k0 + 8 * c) = o; }
    LDS_WAIT(); asm volatile("" ::: "memory");
}
__device__ __forceinline__ void rms_row_to_bf16(const float* xrow, const float* gain, bf16* orow, int lane) {
    const GAS f32x4* xr = (const GAS f32x4*)xrow + lane; const GAS f32x4* gr = (const GAS f32x4*)gain + lane;
    f32x4 v[8]; float s = 0.f;
#pragma unroll
    for (int j = 0; j < 8; ++j) { v[j] = xr[64 * j]; s += (v[j].x * v[j].x + v[j].y * v[j].y) + (v[j].z * v[j].z + v[j].w * v[j].w); }
    const float r = 1.0f / sqrtf(wave_sum(s) * (1.0f / DM) + EPS);
    GAS u32x2* o8 = (GAS u32x2*)orow + lane;
#pragma unroll
    for (int j = 0; j < 8; ++j) { const f32x4 g = gr[64 * j]; u32x2 w; w.x = pk2(v[j].x * r * g.x, v[j].y * r * g.y); w.y = pk2(v[j].z * r * g.z, v[j].w * r * g.w); o8[64 * j] = w; }
}

__device__ __forceinline__ double d_exp(double x) {
    const double k = __builtin_rint(x * 1.4426950408889634074); const double r = (x - k * 0.693147180369123816490) - k * 1.90821492927058770002e-10;
    double p = 1.0 / 6227020800.0;
    p = p * r + 1.0 / 479001600.0; p = p * r + 1.0 / 39916800.0; p = p * r + 1.0 / 3628800.0; p = p * r + 1.0 / 362880.0; p = p * r + 1.0 / 40320.0; p = p * r + 1.0 / 5040.0;
    p = p * r + 1.0 / 720.0; p = p * r + 1.0 / 120.0; p = p * r + 1.0 / 24.0; p = p * r + 1.0 / 6.0; p = p * r + 0.5; p = p * r + 1.0; p = p * r + 1.0;
    const long long ki = (long long)k; const double sc = __builtin_bit_cast(double, (unsigned long long)(ki + 1023) << 52);
    return p * sc;
}
__device__ __forceinline__ void d_sincos(double x, double& s, double& c) {
    const double k = __builtin_rint(x * 0.63661977236758134308); const double r = (x - k * 1.57079632673412561417) - k * 6.07710050650619224932e-11;
    const double r2 = r * r;
    double ps = -1.0 / 121645100408832000.0;
    ps = ps * r2 + 1.0 / 355687428096000.0; ps = ps * r2 - 1.0 / 1307674368000.0; ps = ps * r2 + 1.0 / 6227020800.0; ps = ps * r2 - 1.0 / 39916800.0; ps = ps * r2 + 1.0 / 362880.0;
    ps = ps * r2 - 1.0 / 5040.0; ps = ps * r2 + 1.0 / 120.0; ps = ps * r2 - 1.0 / 6.0; ps = ps * r2 + 1.0; ps = ps * r;
    double pc = 1.0 / 6402373705728000.0;
    pc = -pc; pc = pc * r2 + 1.0 / 20922789888000.0; pc = pc * r2 - 1.0 / 87178291200.0; pc = pc * r2 + 1.0 / 479001600.0; pc = pc * r2 - 1.0 / 3628800.0; pc = pc * r2 + 1.0 / 40320.0;
    pc = pc * r2 - 1.0 / 720.0; pc = pc * r2 + 1.0 / 24.0; pc = pc * r2 - 0.5; pc = pc * r2 + 1.0;
    const int q = ((int)k) & 3;
    s = (q == 0) ? ps : (q == 1) ? pc : (q == 2) ? -ps : -pc;
    c = (q == 0) ? pc : (q == 1) ? -ps : (q == 2) ? -pc : ps;
}

struct TagTrue { static constexpr bool value = true; }; struct TagFalse { static constexpr bool value = false; };
__device__ __forceinline__ void sb_attn_wave(const bf16* PROJ_, const bf16* VT_, bf16* TOK_, const u64* rss_, int b, int h, int qt2, int lane, LAS unsigned char* stg) {
    const GAS bf16* PROJ = (const GAS bf16*)PROJ_; const GAS bf16* VT = (const GAS bf16*)VT_; GAS bf16* TOK = (GAS bf16*)TOK_;
    const GAS u64* RS = (const GAS u64*)rss_ + (size_t)b * SEQ;
    const int fr = lane & 15, fq = lane >> 4;
    const int t0 = qt2 * 32;
    const size_t rowbase = (size_t)b * SEQ;
    bf16x8 qf[2][4]; float scl[2]; int tq[2];
#pragma unroll
    for (int qi = 0; qi < 2; ++qi) { tq[qi] = t0 + 16 * qi + fr;
        const GAS bf16* qp = PROJ + (rowbase + tq[qi]) * PROJ_SB + h * HD + 8 * fq;
#pragma unroll
        for (int ks = 0; ks < 4; ++ks) qf[qi][ks] = *(const GAS bf16x8*)(qp + 32 * ks);
        scl[qi] = (0.08838834764831845f * 1.4426950408889634f) * __builtin_amdgcn_rsqf(rss2f(RS[tq[qi]]) * (1.0f / DM) + EPS); }
    f32x4 o[2][8];
#pragma unroll
    for (int qi = 0; qi < 2; ++qi)
#pragma unroll
        for (int dt = 0; dt < 8; ++dt) o[qi][dt] = (f32x4){0.f, 0.f, 0.f, 0.f};
    float C[2] = {0.f, 0.f};
    const GAS bf16* kbase = PROJ + (rowbase + 8 * (fr >> 2) + (fr & 3)) * PROJ_SB + TOKW + h * HD + 8 * fq;
    const GAS bf16* vbase = VT + (size_t)(h * HD + fr) * M + rowbase + 8 * fq;
    auto step = [&](int kp, auto diag) __attribute__((always_inline)) {
        constexpr bool DIAG = decltype(diag)::value;
        const int kb = kp * 32;
        f32x4 s[2][2];
#pragma unroll
        for (int qi = 0; qi < 2; ++qi) { s[qi][0] = (f32x4){0.f, 0.f, 0.f, 0.f}; s[qi][1] = (f32x4){0.f, 0.f, 0.f, 0.f}; }
        const GAS bf16* k0p = kbase + (size_t)kb * PROJ_SB; const GAS bf16* k1p = k0p + (size_t)4 * PROJ_SB;
#pragma unroll
        for (int ks = 0; ks < 4; ++ks) { const bf16x8 k0 = *(const GAS bf16x8*)(k0p + 32 * ks), k1 = *(const GAS bf16x8*)(k1p + 32 * ks);
#pragma unroll
            for (int qi = 0; qi < 2; ++qi) { s[qi][0] = mfma16(k0, qf[qi][ks], s[qi][0]); s[qi][1] = mfma16(k1, qf[qi][ks], s[qi][1]); } }
        bf16x8 vf[8];
#pragma unroll
        for (int dt = 0; dt < 8; ++dt) vf[dt] = *(const GAS bf16x8*)(vbase + (size_t)(16 * dt) * M + kb);
        float rk[2][4];
#pragma unroll
        for (int T = 0; T < 2; ++T)
#pragma unroll
            for (int r = 0; r < 4; ++r) rk[T][r] = __builtin_amdgcn_rsqf(rss2f(RS[kb + 8 * fq + 4 * T + r]) * (1.0f / DM) + EPS);
#pragma unroll
        for (int qi = 0; qi < 2; ++qi) {
            float ln[2][4], zz[2][4]; bool valid[2][4];
#pragma unroll
            for (int T = 0; T < 2; ++T)
#pragma unroll
                for (int r = 0; r < 4; ++r) { const float z = s[qi][T][r] * scl[qi] * rk[T][r]; valid[T][r] = DIAG ? ((kb + 8 * fq + 4 * T + r) < tq[qi]) : true;
                    const float e = __builtin_amdgcn_exp2f(-fabsf(z)); const float sp = fmaxf(z, 0.f) + __builtin_amdgcn_logf(1.0f + e);
                    ln[T][r] = valid[T][r] ? -sp : 0.f; zz[T][r] = z; }
            float suf[2][4], tot[2];
#pragma unroll
            for (int T = 0; T < 2; ++T) { suf[T][3] = 0.f; suf[T][2] = ln[T][3]; suf[T][1] = ln[T][3] + ln[T][2]; suf[T][0] = suf[T][1] + ln[T][1]; tot[T] = suf[T][0] + ln[T][0]; }
            const float lt = tot[0] + tot[1];
            const float t1 = __shfl_down(lt, 16), t2 = __shfl_down(lt, 32), t3 = __shfl_down(lt, 48);
            const float higher = (fq < 3 ? t1 : 0.f) + (fq < 2 ? t2 : 0.f) + (fq < 1 ? t3 : 0.f);
            float ta = lt + __shfl_xor(lt, 16); ta += __shfl_xor(ta, 32);
            const float base1 = C[qi] + higher, base0 = base1 + tot[1];
            float w[2][4];
#pragma unroll
            for (int r = 0; r < 4; ++r) { w[0][r] = valid[0][r] ? __builtin_amdgcn_exp2f(zz[0][r] + ln[0][r] + base0 + suf[0][r]) * rk[0][r] : 0.f;
                                          w[1][r] = valid[1][r] ? __builtin_amdgcn_exp2f(zz[1][r] + ln[1][r] + base1 + suf[1][r]) * rk[1][r] : 0.f; }
            C[qi] += ta;
            union { bf16x8 v; unsigned u[4]; } pf;
            pf.u[0] = cvt_pk_bf16(w[0][0], w[0][1]); pf.u[1] = cvt_pk_bf16(w[0][2], w[0][3]); pf.u[2] = cvt_pk_bf16(w[1][0], w[1][1]); pf.u[3] = cvt_pk_bf16(w[1][2], w[1][3]);
#pragma unroll
            for (int dt = 0; dt < 8; ++dt) o[qi][dt] = mfma16(vf[dt], pf.v, o[qi][dt]);
        }
        return (bool)__all(C[0] < -57.70780163555854f && C[1] < -57.70780163555854f);
    };
    if (!step(t0 >> 5, TagTrue{})) {
#pragma unroll 1
        for (int kp = (t0 >> 5) - 1; kp >= 0; --kp) if (step(kp, TagFalse{})) break;
    }
#pragma unroll
    for (int qi = 0; qi < 2; ++qi) { LAS unsigned char* sp = stg + (16 * qi + fr) * 272 + 8 * fq;
#pragma unroll
        for (int dt = 0; dt < 8; ++dt) { u32x2 w; w.x = cvt_pk_bf16(o[qi][dt][0], o[qi][dt][1]); w.y = cvt_pk_bf16(o[qi][dt][2], o[qi][dt][3]); *(LAS u32x2*)(sp + 32 * dt) = w; } }
    {
        u32x4 w[8];
#pragma unroll
        for (int i = 0; i < 8; ++i) w[i] = *(LAS u32x4*)(stg + (4 * i + fq) * 272 + 16 * fr);
        GAS bf16* op = TOK + (rowbase + t0 + fq) * DM + h * HD + 8 * fr;
#pragma unroll
        for (int i = 0; i < 8; ++i) *(GAS u32x4*)(op + (size_t)(4 * i) * DM) = w[i];
    }
}

__device__ __forceinline__ void cross_attn_wave(const bf16* PROJ_, int ldp, int qoff, LAS unsigned char* lds, bf16* TOK_, const u64* rss_, int b, int hm, int qt2, int lane) {
    const GAS bf16* PROJ = (const GAS bf16*)PROJ_; GAS bf16* TOK = (GAS bf16*)TOK_;
    const int fr = lane & 15, fq = lane >> 4;
    bf16x8 qf[2][4]; float rq[2]; size_t row[2];
#pragma unroll
    for (int qi = 0; qi < 2; ++qi) { row[qi] = (size_t)b * SEQ + qt2 * 32 + 16 * qi + fr; float ss = 0.f;
        const GAS bf16* qp = PROJ + row[qi] * ldp + qoff + hm * HD + 8 * fq;
#pragma unroll
        for (int ks = 0; ks < 4; ++ks) { qf[qi][ks] = *(const GAS bf16x8*)(qp + 32 * ks);
#pragma unroll
            for (int j = 0; j < 8; ++j) { const float q = bf2f((unsigned short)qf[qi][ks][j]); ss += q * q; } }
        ss += __shfl_xor(ss, 16); ss += __shfl_xor(ss, 32);
        const float eps2 = EPS * (rss2f(((const GAS u64*)rss_)[row[qi]]) * (1.0f / DM) + EPS);
        rq[qi] = (1.0f / sqrtf(ss * (1.0f / HD) + eps2)) * (0.08838834764831845f * 1.4426950408889634f); }
    f32x4 o[2][8];
#pragma unroll
    for (int qi = 0; qi < 2; ++qi)
#pragma unroll
        for (int dt = 0; dt < 8; ++dt) o[qi][dt] = (f32x4){0.f, 0.f, 0.f, 0.f};
    float mrun[2] = {-1e30f, -1e30f}, lrun[2] = {0.f, 0.f};
    LAS unsigned char* kbase = lds + (8 * (fr >> 2) + (fr & 3)) * XK_ROWB + 16 * fq;
    LAS unsigned char* vbase = lds + XV_OFF + fr * XV_ROWB + 16 * fq;
#pragma unroll 1
    for (int kp = 0; kp < 8; ++kp) {
        const int kb = kp * 32;
        f32x4 s[2][2];
#pragma unroll
        for (int qi = 0; qi < 2; ++qi) { s[qi][0] = (f32x4){0.f, 0.f, 0.f, 0.f}; s[qi][1] = (f32x4){0.f, 0.f, 0.f, 0.f}; }
#pragma unroll
        for (int ks = 0; ks < 4; ++ks) { const bf16x8 k0 = *(const LAS bf16x8*)(kbase + kb * XK_ROWB + 64 * ks), k1 = *(const LAS bf16x8*)(kbase + (kb + 4) * XK_ROWB + 64 * ks);
#pragma unroll
            for (int qi = 0; qi < 2; ++qi) { s[qi][0] = mfma16(k0, qf[qi][ks], s[qi][0]); s[qi][1] = mfma16(k1, qf[qi][ks], s[qi][1]); } }
        bf16x8 vf[8];
#pragma unroll
        for (int dt = 0; dt < 8; ++dt) vf[dt] = *(const LAS bf16x8*)(vbase + 16 * dt * XV_ROWB + 2 * kb);
#pragma unroll
        for (int qi = 0; qi < 2; ++qi) {
            float mx = -1e30f;
#pragma unroll
            for (int r = 0; r < 4; ++r) { s[qi][0][r] *= rq[qi]; s[qi][1][r] *= rq[qi]; mx = fmaxf(mx, fmaxf(s[qi][0][r], s[qi][1][r])); }
            mx = fmaxf(mx, __shfl_xor(mx, 16)); mx = fmaxf(mx, __shfl_xor(mx, 32));
            if (__any(mx > mrun[qi] + 8.0f)) {
                const float mnew = fmaxf(mrun[qi], mx), corr = __builtin_amdgcn_exp2f(mrun[qi] - mnew);
#pragma unroll
                for (int dt = 0; dt < 8; ++dt) o[qi][dt] = o[qi][dt] * corr;
                lrun[qi] *= corr; mrun[qi] = mnew; }
            const float mref = mrun[qi];
            float p0[4], p1[4], ps = 0.f;
#pragma unroll
            for (int r = 0; r < 4; ++r) { p0[r] = __builtin_amdgcn_exp2f(s[qi][0][r] - mref); p1[r] = __builtin_amdgcn_exp2f(s[qi][1][r] - mref); ps += p0[r] + p1[r]; }
            ps += __shfl_xor(ps, 16); ps += __shfl_xor(ps, 32);
            lrun[qi] += ps;
            union { bf16x8 v; unsigned u[4]; } pf;
            pf.u[0] = cvt_pk_bf16(p0[0], p0[1]); pf.u[1] = cvt_pk_bf16(p0[2], p0[3]); pf.u[2] = cvt_pk_bf16(p1[0], p1[1]); pf.u[3] = cvt_pk_bf16(p1[2], p1[3]);
#pragma unroll
            for (int dt = 0; dt < 8; ++dt) o[qi][dt] = mfma16(vf[dt], pf.v, o[qi][dt]);
        }
    }
#pragma unroll
    for (int qi = 0; qi < 2; ++qi) { const float inv = 1.0f / lrun[qi];
        GAS bf16* op = TOK + row[qi] * DM + TOKW + hm * HD + 4 * fq;
#pragma unroll
        for (int dt = 0; dt < 8; ++dt) { u32x2 w; w.x = cvt_pk_bf16(o[qi][dt][0] * inv, o[qi][dt][1] * inv); w.y = cvt_pk_bf16(o[qi][dt][2] * inv, o[qi][dt][3] * inv); *(GAS u32x2*)(op + 16 * dt) = w; } }
}

constexpr int S5_LDS_WAVE = 12800;
template <int PASS>
__device__ __forceinline__ void s5_wave(const bf16* PROJ_, const bf16* Bbar_, const bf16* Ccat_, const float* ABAR_, const float* dskip_, float* E_, bf16* Y_, const u64* rss_,
                                        int b, int g, int c, LAS unsigned char* wl, int lane) {
    const GAS bf16* PROJ = (const GAS bf16*)PROJ_; const GAS bf16* Bbar = (const GAS bf16*)Bbar_; const GAS bf16* Ccat = (const GAS bf16*)Ccat_;
    const GAS float* ABAR = (const GAS float*)ABAR_; const GAS float* dskip = (const GAS float*)dskip_; GAS float* E = (GAS float*)E_; GAS bf16* Y = (GAS bf16*)Y_;
    const int fr = lane & 15, fq = lane >> 4;
    LAS float* BUs = (LAS float*)wl; LAS bf16* Ss = (LAS bf16*)(wl + 8448);
    const bf16x8 zero8 = (bf16x8){0, 0, 0, 0, 0, 0, 0, 0};
    const size_t row0 = (size_t)b * SEQ + (size_t)c * S5T;
    const GAS bf16* up = PROJ + (row0 + fr) * PROJ_S5 + g * 16;
    const GAS u64* RS = (const GAS u64*)rss_ + row0 + fr;
    bf16x8 ufn = *(const GAS bf16x8*)(up + 8 * (fq & 1)); bf16x4 u4n = *(const GAS bf16x4*)(up + 4 * fq); u64 rsn = RS[0];
    bf16x8 bb[8];
#pragma unroll
    for (int mt = 0; mt < 8; ++mt) { const bf16x8 t = *(const GAS bf16x8*)(Bbar + ((size_t)g * 128 + 16 * mt + fr) * 16 + 8 * (fq & 1)); bb[mt] = (fq < 2) ? t : zero8; }
    const f32x4 ab = *(const GAS f32x4*)(ABAR + ((size_t)g * 64 + lane) * 4);
    bf16x8 cc[4]; f32x4 dv = (f32x4){0.f, 0.f, 0.f, 0.f};
    if (PASS == 1) {
#pragma unroll
        for (int ks = 0; ks < 4; ++ks) cc[ks] = *(const GAS bf16x8*)(Ccat + ((size_t)g * 16 + fr) * 128 + 32 * ks + 8 * fq);
        dv = *(const GAS f32x4*)(dskip + g * 16 + 4 * fq);
    }
    float sre = 0.f, sim = 0.f;
    const f32x2 a00 = (f32x2){ab[0], ab[0]}, a11 = (f32x2){-ab[1], ab[1]};
    GAS float* Ebg = E + ((size_t)(b * S5G + g) * S5NC) * 128;
    if (PASS == 1) {
        int jc = 0;
#pragma unroll 1
        for (; jc + 8 <= c; jc += 8) { f32x2 e[8];
#pragma unroll
            for (int k = 0; k < 8; ++k) e[k] = *(const GAS f32x2*)(Ebg + (size_t)(jc + k) * 128 + 2 * lane);
#pragma unroll
            for (int k = 0; k < 8; ++k) { const float nre = ab[2] * sre - ab[3] * sim + e[k].x, nim = ab[2] * sim + ab[3] * sre + e[k].y; sre = nre; sim = nim; } }
#pragma unroll 1
        for (; jc < c; ++jc) { const f32x2 e = *(const GAS f32x2*)(Ebg + (size_t)jc * 128 + 2 * lane);
            const float nre = ab[2] * sre - ab[3] * sim + e.x, nim = ab[2] * sim + ab[3] * sre + e.y; sre = nre; sim = nim; }
    }
#pragma unroll 1
    for (int sb = 0; sb < S5T / 16; ++sb) {
          const bf16x8 uf = ufn; const bf16x4 u4 = u4n; const float rt = __builtin_amdgcn_rsqf(rss2f(rsn) * (1.0f / DM) + EPS);
        if (sb < S5T / 16 - 1) { const GAS bf16* un = up + (size_t)(sb + 1) * 16 * PROJ_S5;
            ufn = *(const GAS bf16x8*)(un + 8 * (fq & 1)); u4n = *(const GAS bf16x4*)(un + 4 * fq); rsn = RS[(sb + 1) * 16]; }
#pragma unroll
        for (int mt = 0; mt < 8; ++mt) { const f32x4 bu = mfma16(bb[mt], uf, (f32x4){0.f, 0.f, 0.f, 0.f}) * rt;
            *(LAS f32x4*)(BUs + fr * 132 + 16 * mt + 4 * fq) = bu; }
        LDS_WAIT(); asm volatile("" ::: "memory");
        f32x2 bt[16];
#pragma unroll
        for (int t = 0; t < 16; ++t) bt[t] = *(const LAS f32x2*)(BUs + t * 132 + 2 * lane);
        LDS_WAIT(); asm volatile("" ::: "memory");
        f32x2 sv = (f32x2){sre, sim};
#pragma unroll
        for (int t = 0; t < 16; ++t) {
            f32x2 tt, s2;
            asm("v_pk_fma_f32 %0, %1, %2, %3" : "=v"(tt) : "v"(a00), "v"(sv), "v"(bt[t]));
            asm("v_pk_fma_f32 %0, %1, %2, %3 op_sel:[0,1,0] op_sel_hi:[1,0,1]" : "=v"(s2) : "v"(a11), "v"(sv), "v"(tt));
            sv = s2;
            if (PASS == 1) *(LAS unsigned*)(Ss + t * 136 + 2 * lane) = cvt_pk_bf16(sv.x, sv.y); }
        sre = sv.x; sim = sv.y;
        if (PASS == 1) {
            LDS_WAIT(); asm volatile("" ::: "memory");
            f32x4 y = (f32x4){0.f, 0.f, 0.f, 0.f};
#pragma unroll
            for (int ks = 0; ks < 4; ++ks) { const bf16x8 sf = *(const LAS bf16x8*)(Ss + fr * 136 + 32 * ks + 8 * fq); y = mfma16(cc[ks], sf, y); }
            f32x2 v2[2], e2[2];
#pragma unroll
            for (int q = 0; q < 2; ++q) { const f32x2 uu = (f32x2){bf2f((unsigned short)u4[2 * q]), bf2f((unsigned short)u4[2 * q + 1])} * rt;
                v2[q] = (f32x2){y[2 * q], y[2 * q + 1]} + (f32x2){dv[2 * q], dv[2 * q + 1]} * uu;
                const f32x2 vv = v2[q] * v2[q]; e2[q] = (v2[q] * (-2.0f * 0.7978845608028654f * 1.4426950408889634f)) * (vv * 0.044715f + 1.0f); }
#pragma unroll
            for (int q = 0; q < 2; ++q) { e2[q].x = __builtin_amdgcn_exp2f(e2[q].x); e2[q].y = __builtin_amdgcn_exp2f(e2[q].y); }
#pragma unroll
            for (int q = 0; q < 2; ++q) e2[q] = e2[q] + 1.0f;
#pragma unroll
            for (int q = 0; q < 2; ++q) { e2[q].x = __builtin_amdgcn_rcpf(e2[q].x); e2[q].y = __builtin_amdgcn_rcpf(e2[q].y); }
            const f32x2 o0 = v2[0] * e2[0], o1 = v2[1] * e2[1];
            u32x2 w; w.x = cvt_pk_bf16(o0.x, o0.y); w.y = cvt_pk_bf16(o1.x, o1.y);
            *(GAS u32x2*)(Y + (row0 + sb * 16 + fr) * TOKW + g * 16 + 4 * fq) = w;
        }
        LDS_WAIT(); asm volatile("" ::: "memory");
        __builtin_amdgcn_sched_barrier(0);
        asm volatile("" : "+v"(ufn), "+v"(u4n), "+v"(rsn));
    }
    if (PASS == 0) *(GAS f32x2*)(Ebg + (size_t)c * 128 + 2 * lane) = (f32x2){sre, sim};
}

__device__ __forceinline__ void s5_pass0_wave(const bf16* PROJ_, const bf16* Bbar_, const float* ABAR_, float* E_, const u64* rss_, int b, int g, int c, LAS unsigned char* wl, int lane) {
    const GAS bf16* PROJ = (const GAS bf16*)PROJ_; const GAS bf16* Bbar = (const GAS bf16*)Bbar_; const GAS float* ABAR = (const GAS float*)ABAR_; GAS float* E = (GAS float*)E_;
    const int fr = lane & 15, fq = lane >> 4;
    const bf16x8 zero8 = (bf16x8){0, 0, 0, 0, 0, 0, 0, 0};
    const size_t row0 = (size_t)b * SEQ + (size_t)c * S5T;
    const GAS bf16* up = PROJ + (row0 + fr) * PROJ_S5 + g * 16 + 8 * (fq & 1);
    bf16x8 ufn[4];
#pragma unroll
    for (int i = 0; i < 4; ++i) ufn[i] = *(const GAS bf16x8*)(up + (size_t)i * 16 * PROJ_S5);
    LAS float* rtl = (LAS float*)wl;
    {
        const GAS u64* RS = (const GAS u64*)rss_ + row0 + 4 * lane;
        const u64 r0 = RS[0], r1 = RS[1], r2 = RS[2], r3 = RS[3];
        f32x4 rv; rv[0] = __builtin_amdgcn_rsqf(rss2f(r0) * (1.0f / DM) + EPS); rv[1] = __builtin_amdgcn_rsqf(rss2f(r1) * (1.0f / DM) + EPS);
        rv[2] = __builtin_amdgcn_rsqf(rss2f(r2) * (1.0f / DM) + EPS); rv[3] = __builtin_amdgcn_rsqf(rss2f(r3) * (1.0f / DM) + EPS);
        *(LAS f32x4*)(rtl + 4 * lane) = rv;
    }
    bf16x8 bre[4], bim[4];
    float are[4], aim[4], gre[4], gim[4];
#pragma unroll
    for (int j = 0; j < 4; ++j) { const GAS bf16* bp = Bbar + ((size_t)g * 128 + 2 * (16 * j + fr)) * 16 + 8 * (fq & 1);
        const bf16x8 t0 = *(const GAS bf16x8*)bp, t1 = *(const GAS bf16x8*)(bp + 16); bre[j] = (fq < 2) ? t0 : zero8; bim[j] = (fq < 2) ? t1 : zero8;
        const f32x2 a = *(const GAS f32x2*)(ABAR + ((size_t)g * 64 + 16 * j + fr) * 4);
        are[j] = a.x; aim[j] = a.y;
        const float a2r = a.x * a.x - a.y * a.y, a2i = 2.0f * a.x * a.y;
        const float a4r = a2r * a2r - a2i * a2i, a4i = 2.0f * a2r * a2i;
        const float a8r = a4r * a4r - a4i * a4i, a8i = 2.0f * a4r * a4i;
        const float a12r = a8r * a4r - a8i * a4i, a12i = a8r * a4i + a8i * a4r;
        gre[j] = a12r * a.x - a12i * a.y; gim[j] = a12r * a.y + a12i * a.x; }
    float Rre[4] = {0.f, 0.f, 0.f, 0.f}, Rim[4] = {0.f, 0.f, 0.f, 0.f};
    LDS_WAIT(); asm volatile("" ::: "memory");
#pragma unroll 1
    for (int h = 0; h < S5T / 64; ++h) {
      bf16x8 ufc[4];
#pragma unroll
      for (int i = 0; i < 4; ++i) ufc[i] = ufn[i];
      if (h < S5T / 64 - 1) {
#pragma unroll
          for (int i = 0; i < 4; ++i) ufn[i] = *(const GAS bf16x8*)(up + (size_t)((h + 1) * 4 + i) * 16 * PROJ_S5); }
#pragma unroll
      for (int i = 0; i < 4; ++i) { const int sb = h * 4 + i;
        const bf16x8 uf = ufc[i];
        const f32x4 rt = *(const LAS f32x4*)(rtl + 16 * sb + 4 * fq);
#pragma unroll
        for (int j = 0; j < 4; ++j) {
            const f32x4 br = mfma16(uf, bre[j], (f32x4){0.f, 0.f, 0.f, 0.f}) * rt, bi = mfma16(uf, bim[j], (f32x4){0.f, 0.f, 0.f, 0.f}) * rt;
            float nr = __builtin_fmaf(-gim[j], Rim[j], __builtin_fmaf(gre[j], Rre[j], br[0])), ni = __builtin_fmaf(gim[j], Rre[j], __builtin_fmaf(gre[j], Rim[j], bi[0]));
#pragma unroll
            for (int r = 1; r < 4; ++r) { const float tr = __builtin_fmaf(-aim[j], ni, __builtin_fmaf(are[j], nr, br[r])), ti = __builtin_fmaf(aim[j], nr, __builtin_fmaf(are[j], ni, bi[r])); nr = tr; ni = ti; }
            Rre[j] = nr; Rim[j] = ni; }
        __builtin_amdgcn_sched_barrier(0);
      }
      asm volatile("" : "+v"(ufn[0]), "+v"(ufn[1]), "+v"(ufn[2]), "+v"(ufn[3]));
    }
    float ore = 0.f, oim = 0.f;
#pragma unroll
    for (int j = 0; j < 4; ++j) {
        const float a2r = are[j] * are[j] - aim[j] * aim[j], a2i = 2.0f * are[j] * aim[j];
        const float a4r = a2r * a2r - a2i * a2i, a4i = 2.0f * a2r * a2i;
        const float a8r = a4r * a4r - a4i * a4i, a8i = 2.0f * a4r * a4i;
        const float a12r = a8r * a4r - a8i * a4i, a12i = a8r * a4i + a8i * a4r;
        const float wr = fq == 0 ? a12r : fq == 1 ? a8r : fq == 2 ? a4r : 1.0f, wi = fq == 0 ? a12i : fq == 1 ? a8i : fq == 2 ? a4i : 0.0f;
        float xr = wr * Rre[j] - wi * Rim[j], xi = wr * Rim[j] + wi * Rre[j];
        xr += __shfl_xor(xr, 16); xi += __shfl_xor(xi, 16); xr += __shfl_xor(xr, 32); xi += __shfl_xor(xi, 32);
        if (fq == j) { ore = xr; oim = xi; } }
    *(GAS f32x2*)(E + ((size_t)(b * S5G + g) * S5NC + c) * 128 + 2 * lane) = (f32x2){ore, oim};
}

struct Args { const float* in[25]; float* out; unsigned char* ws; };
enum { I_X = 0, I_MEM, I_F1N, I_F1GU, I_F1DN, I_MIXN, I_MEMN, I_WKV, I_XQN, I_XKN, I_WOUT, I_F2N, I_F2GU, I_F2DN, I_SBIN, I_S5IN, I_LOGDT, I_ARE, I_AIM, I_BRE, I_BIM, I_CRE, I_CIM, I_S5D, I_WGLU };

__device__ __forceinline__ void cross_attn_phase(const bf16* PROJ, int ldp, int qoff, const bf16* KNl, const bf16* VTMl, bf16* TOK, const u64* rss, LAS unsigned char* lds, int vcu, int G, int tid, int wave, int lane) {
#pragma unroll 1
    for (int base = vcu * 8; base < BATCH * MEMHEADS * (SEQ / 32); base += G * 8) {
        const int bh = base >> 8;
        const GAS bf16* kn = (const GAS bf16*)KNl + (size_t)bh * NMEM * HD; const GAS bf16* vt = (const GAS bf16*)VTMl + (size_t)bh * HD * NMEM;
        __syncthreads();
        { u32x4 kv[8], vv[8];
#pragma unroll
          for (int it = 0; it < 8; ++it) { const int ch = tid + 512 * it; kv[it] = *(const GAS u32x4*)(kn + (size_t)(ch >> 4) * HD + 8 * (ch & 15)); vv[it] = *(const GAS u32x4*)(vt + (size_t)(ch >> 5) * NMEM + 8 * (ch & 31)); }
#pragma unroll
          for (int it = 0; it < 8; ++it) { const int ch = tid + 512 * it; *(LAS u32x4*)(lds + (ch >> 4) * XK_ROWB + 16 * (ch & 15)) = kv[it]; *(LAS u32x4*)(lds + XV_OFF + (ch >> 5) * XV_ROWB + 16 * (ch & 31)) = vv[it]; } }
        asm volatile("s_waitcnt vmcnt(0) lgkmcnt(0)" ::: "memory"); __syncthreads();
        const int v = base + wave; cross_attn_wave(PROJ, ldp, qoff, lds, TOK, rss, bh / MEMHEADS, bh % MEMHEADS, v & 255, lane);
    }
    __syncthreads();
}

#define PHASE_VARS \
    int ptid = threadIdx.x; asm volatile("" : "+v"(ptid)); \
    const int lane = ptid & 63; const int wave = __builtin_amdgcn_readfirstlane(ptid >> 6); \
    const int gw = vcu * 8 + wave; \
    unsigned char* ws = args.ws; asm volatile("" : "+s"(ws)); \
    float* out = args.out; asm volatile("" : "+s"(out)); \
    (void)lane; (void)gw; (void)out;
#define P_WGU1 ((bf16*)(ws + WS_WGU1))
#define P_WDN1 ((bf16*)(ws + WS_WDN1))
#define P_WGU2 ((bf16*)(ws + WS_WGU2))
#define P_WDN2 ((bf16*)(ws + WS_WDN2))
#define P_WOUT ((bf16*)(ws + WS_WOUT))
#define P_WKV ((bf16*)(ws + WS_WKV))
#define P_WINSB ((bf16*)(ws + WS_WINSB))
#define P_WINS5 ((bf16*)(ws + WS_WINS5))
#define P_WGLU ((bf16*)(ws + WS_WGLU))
#define P_XN ((bf16*)(ws + WS_XN))
#define P_ACT ((bf16*)(ws + WS_ACT))
#define P_PROJ ((bf16*)(ws + WS_PROJ))
#define P_VT ((bf16*)(ws + WS_VT))
#define P_YB ((bf16*)(ws + WS_VT))
#define P_TOK ((bf16*)(ws + WS_TOK))
#define P_MEMH ((bf16*)(ws + WS_MEMH))
#define P_KVM ((bf16*)(ws + WS_KVM))
#define P_KN ((bf16*)(ws + WS_KN))
#define P_VTM ((bf16*)(ws + WS_VTM))
#define P_BBAR ((bf16*)(ws + WS_BBAR))
#define P_CCAT ((bf16*)(ws + WS_CCAT))
#define P_ABAR ((float*)(ws + WS_ABAR))
#define P_EB ((float*)(ws + WS_E))
#define P_RSS ((u64*)(ws + WS_RSS))

__global__ void __launch_bounds__(512, 2) fwd(Args args) {
    extern __shared__ __attribute__((aligned(16))) unsigned char lds_raw[];
    LAS unsigned char* lds = (LAS unsigned char*)lds_raw;
    const int G = gridDim.x; const int bx = blockIdx.x; const int vcu = (G % 8 == 0) ? (bx % 8) * (G / 8) + bx / 8 : bx;
    const int NGW = G * 8;
    for (int u = threadIdx.x; u < (LDS_BYTES - LDSCTL_OFF) / 4; u += 512) ((LAS unsigned*)(lds + LDSCTL_OFF))[u] = 0u;
    __syncthreads();
    XcdBarrier bar = xcd_barrier_post((unsigned*)(args.ws + WS_CTL) + CW_BAR, (volatile LAS unsigned*)(lds + MISC_OFF) + 8);
#define GRID_BAR() xcd_barrier(bar)

    {
        PHASE_VARS
        LAS float* scr = (LAS float*)(lds + wave * 16384);
        constexpr int IT_GU = (DM / 64) * (2 * FFN / 32), IT_DN = (FFN / 64) * (DM / 32), IT_OUT = (DM / 64) * (DM / 32), IT_KV = (DM / 64) * (1024 / 32);
        constexpr int IT_INSB = (DM / 64) * (5120 / 32), IT_INS5 = (DM / 64) * (DM / 32), IT_GLU = (TOKW / 64) * (TOKW / 32);
        constexpr int NITEMS = 4 * (2 * IT_GU + 2 * IT_DN + IT_OUT + IT_KV) + 2 * (IT_INSB + IT_INS5 + IT_GLU);
#pragma unroll 1
        for (int it = gw; it < NITEMS; it += NGW) {
            int r = it;
            if (r < 8 * IT_GU) {
                const int which = r / (4 * IT_GU); r -= which * 4 * IT_GU; const int layer = r / IT_GU; r -= layer * IT_GU;
                const int nblk = 2 * FFN / 32, kb = r / nblk, nb = r % nblk, n0 = 32 * nb, bj = n0 / FFN, jj = n0 % FFN, drow0 = 256 * (jj / 128) + 128 * bj + (jj % 128);
                transpose_item(args.in[which ? I_F2GU : I_F1GU] + (size_t)layer * DM * 2 * FFN, DM, 2 * FFN, (which ? P_WGU2 : P_WGU1) + (size_t)layer * 2 * FFN * DM, 64 * kb, n0, drow0, scr, lane, args.in[which ? I_F2N : I_F1N] + (size_t)layer * DM);
                continue; }
            r -= 8 * IT_GU;
            if (r < 8 * IT_DN) {
                const int which = r / (4 * IT_DN); r -= which * 4 * IT_DN; const int layer = r / IT_DN; r -= layer * IT_DN;
                const int nblk = DM / 32, kb = r / nblk, nb = r % nblk;
                transpose_item(args.in[which ? I_F2DN : I_F1DN] + (size_t)layer * FFN * DM, FFN, DM, (which ? P_WDN2 : P_WDN1) + (size_t)layer * DM * FFN, 64 * kb, 32 * nb, 32 * nb, scr, lane);
                continue; }
            r -= 8 * IT_DN;
            if (r < 4 * IT_OUT) {
                const int layer = r / IT_OUT; r -= layer * IT_OUT; const int nblk = DM / 32, kb = r / nblk, nb = r % nblk;
                transpose_item(args.in[I_WOUT] + (size_t)layer * DM * DM, DM, DM, P_WOUT + (size_t)layer * DM * DM, 64 * kb, 32 * nb, 32 * nb, scr, lane);
                continue; }
            r -= 4 * IT_OUT;
            if (r < 4 * IT_KV) {
                const int layer = r / IT_KV; r -= layer * IT_KV; const int nblk = 1024 / 32, kb = r / nblk, nb = r % nblk;
                transpose_item(args.in[I_WKV] + (size_t)layer * DM * 1024, DM, 1024, P_WKV + (size_t)layer * 1024 * DM, 64 * kb, 32 * nb, 32 * nb, scr, lane);
                continue; }
            r -= 4 * IT_KV;
            if (r < 2 * IT_INSB) {
                const int j = r / IT_INSB; r -= j * IT_INSB; const int nblk = 5120 / 32, kb = r / nblk, nb = r % nblk, n0 = 32 * nb;
                const int drow0 = (n0 < 3072) ? n0 : (n0 < 4608 ? n0 + 512 : n0 - 1536);
                transpose_item(args.in[I_SBIN] + (size_t)j * DM * 5120, DM, 5120, P_WINSB + (size_t)j * 5120 * DM, 64 * kb, n0, drow0, scr, lane, args.in[I_MIXN] + (size_t)(2 * j) * DM);
                continue; }
            r -= 2 * IT_INSB;
            if (r < 2 * IT_INS5) {
                const int j = r / IT_INS5; r -= j * IT_INS5; const int nblk = DM / 32, kb = r / nblk, nb = r % nblk;
                transpose_item(args.in[I_S5IN] + (size_t)j * DM * DM, DM, DM, P_WINS5 + (size_t)j * DM * DM, 64 * kb, 32 * nb, 32 * nb, scr, lane, args.in[I_MIXN] + (size_t)(2 * j + 1) * DM);
                continue; }
            r -= 2 * IT_INS5;
            { const int j = r / IT_GLU; r -= j * IT_GLU; const int nblk = TOKW / 32, kb = r / nblk, nb = r % nblk;
              transpose_item(args.in[I_WGLU] + (size_t)j * TOKW * TOKW, TOKW, TOKW, P_WGLU + (size_t)j * TOKW * TOKW, 64 * kb, 32 * nb, 32 * nb, scr, lane); }
        }
#pragma unroll 1
        for (int m = gw; m < 4 * 512; m += NGW) { const int layer = m >> 9, rr = m & 511;
            rms_row_to_bf16(args.in[I_MEM] + (size_t)rr * DM, args.in[I_MEMN] + (size_t)layer * DM, P_MEMH + (size_t)m * DM, lane); }
#pragma unroll 1
        for (int idx = gw * 64 + lane; idx < 2 * S5G * S5N; idx += NGW * 64) {
            const int j = idx / (S5G * S5N), g = (idx / S5N) % S5G, n = idx % S5N;
            const double dt = d_exp((double)args.in[I_LOGDT][j * S5G + g]);
            const double lre = (double)args.in[I_ARE][(j * S5G + g) * S5N + n], lim = (double)args.in[I_AIM][(j * S5G + g) * S5N + n];
            const double ea = d_exp(lre * dt); double sn, cs; d_sincos(lim * dt, sn, cs);
            const double are = ea * cs, aim = ea * sn;
            const double nr = are - 1.0, ni = aim, den = lre * lre + lim * lim;
            const double cre = (nr * lre + ni * lim) / den, cim = (ni * lre - nr * lim) / den;
            const float* bre = args.in[I_BRE] + ((size_t)(j * S5G + g) * S5N + n) * S5C; const float* bim = args.in[I_BIM] + ((size_t)(j * S5G + g) * S5N + n) * S5C;
            bf16* bo = P_BBAR + ((size_t)(j * S5G + g) * 128 + 2 * n) * 16;
#pragma unroll 1
            for (int c = 0; c < S5C; ++c) { const double br = bre[c], bi = bim[c]; bo[c] = (bf16)f2bf((float)(cre * br - cim * bi)); bo[16 + c] = (bf16)f2bf((float)(cre * bi + cim * br)); }
            const float* cr = args.in[I_CRE] + (size_t)(j * S5G + g) * S5C * S5N; const float* ci = args.in[I_CIM] + (size_t)(j * S5G + g) * S5C * S5N;
            bf16* co = P_CCAT + (size_t)(j * S5G + g) * 16 * 128;
#pragma unroll 1
            for (int c = 0; c < S5C; ++c) { co[c * 128 + 2 * n] = (bf16)f2bf(cr[c * S5N + n]); co[c * 128 + 2 * n + 1] = (bf16)f2bf(-ci[c * S5N + n]); }
            double tr = are, ti = aim;
#pragma unroll 1
            for (int s = 0; s < S5T_LOG2; ++s) { const double t2r = tr * tr - ti * ti, t2i = 2.0 * tr * ti; tr = t2r; ti = t2i; }
            *(f32x4*)(P_ABAR + ((size_t)(j * S5G + g) * 64 + n) * 4) = (f32x4){(float)are, (float)aim, (float)tr, (float)ti};
        }
    }
    GRID_BAR();
    {
        PHASE_VARS
        pg8::KvSched S; S.A = (const char*)P_MEMH; S.B = (const char*)P_WKV; S.tstep = (size_t)256 * DM * 2; S.G = G; S.c = bx;
        pg8::EpiBf16 E{P_KVM, 1024, P_KVM, 1024, 3};
        pg8::gemm_phase<pg8::EpiBf16, pg8::KvSched, true, true>(lds, DM, S, E, ptid);
        const int nkv = (G > 64) ? 32 : 0;
        if (bx >= nkv) {
            const int gw2 = (bx - nkv) * 8 + wave, ngw2 = (G - nkv) * 8;
#pragma unroll 1
            for (int m = gw2; m < M; m += ngw2) {
                const GAS f32x4* xr = (const GAS f32x4*)(args.in[I_X] + (size_t)m * DM) + lane; GAS u32x2* o8 = (GAS u32x2*)(P_XN + (size_t)m * DM) + lane; float s = 0.f;
#pragma unroll
                for (int j = 0; j < 8; ++j) { const f32x4 v = xr[64 * j]; s += (v.x * v.x + v.y * v.y) + (v.z * v.z + v.w * v.w); u32x2 w; w.x = pk2(v.x, v.y); w.y = pk2(v.z, v.w); o8[64 * j] = w; }
                s = wave_sum(s); if (lane == 0) ((GAS u64*)P_RSS)[m] = (u64)(s * 1048576.0f + 0.5f);
            }
        }
    }
    GRID_BAR();
    {
        PHASE_VARS
#pragma unroll 1
        for (int rr = gw; rr < 4 * 512; rr += NGW) {
            const int layer = rr >> 9, b = (rr >> 8) & 1, m = rr & 255;
            const GAS bf16* kvrow = (const GAS bf16*)P_KVM + (size_t)rr * 1024;
            const int hm = lane >> 4, d0 = (lane & 15) * 8;
            const bf16x8 kv = *(const GAS bf16x8*)(kvrow + lane * 8); const bf16x8 vv = *(const GAS bf16x8*)(kvrow + 512 + lane * 8);
            float kf[8], ss = 0.f;
#pragma unroll
            for (int j = 0; j < 8; ++j) { kf[j] = bf2f((unsigned short)kv[j]); ss += kf[j] * kf[j]; }
            ss += __shfl_xor(ss, 1); ss += __shfl_xor(ss, 2); ss += __shfl_xor(ss, 4); ss += __shfl_xor(ss, 8);
            const float rk = 1.0f / sqrtf(ss * (1.0f / HD) + EPS);
            const GAS float* kg = (const GAS float*)args.in[I_XKN] + layer * HD + d0; const GAS float* qg = (const GAS float*)args.in[I_XQN] + layer * HD + d0;
            u32x4 w; unsigned wv[4];
#pragma unroll
            for (int j = 0; j < 4; ++j) wv[j] = pk2(kf[2 * j] * rk * kg[2 * j] * qg[2 * j], kf[2 * j + 1] * rk * kg[2 * j + 1] * qg[2 * j + 1]);
            w.x = wv[0]; w.y = wv[1]; w.z = wv[2]; w.w = wv[3];
            *(GAS u32x4*)((GAS bf16*)P_KN + ((size_t)((layer * 2 + b) * 4 + hm) * NMEM + m) * HD + d0) = w;
            GAS bf16* vt = (GAS bf16*)P_VTM + ((size_t)((layer * 2 + b) * 4 + hm) * HD + d0) * NMEM + m;
#pragma unroll
            for (int j = 0; j < 8; ++j) vt[(size_t)j * NMEM] = (bf16)vv[j];
        }
    }

#pragma unroll 1
    for (int layer = 0; layer < DEPTH; ++layer) {
        const int jj = layer >> 1; const bool is_sb = (layer & 1) == 0;
#pragma unroll 1
        for (int half = 0; half < 2; ++half) {
            const int cslot = 3 * layer + 2 * half;
            { PHASE_VARS
              pg8::DualSched S; S.t1.init(M, 2 * FFN); S.t2.init(0, 0); S.A1 = (const char*)P_XN; S.B1 = (const char*)((half ? P_WGU2 : P_WGU1) + (size_t)layer * 2 * FFN * DM); S.A2 = S.A1; S.B2 = S.B1;
              S.tstep = (size_t)256 * DM * 2; S.G = G; S.c = bx;
              pg8::EpiSwiGLU E{P_ACT, FFN, P_RSS + (size_t)cslot * M};
              pg8::gemm_phase<pg8::EpiSwiGLU, pg8::DualSched, true, true>(lds, DM, S, E, ptid); }
            GRID_BAR();
            { PHASE_VARS
              pg8::DualSched S; S.t1.init(M, DM); S.t2.init(0, 0); S.A1 = (const char*)P_ACT; S.B1 = (const char*)((half ? P_WDN2 : P_WDN1) + (size_t)layer * DM * FFN); S.A2 = S.A1; S.B2 = S.B1;
              S.tstep = (size_t)256 * FFN * 2; S.G = G; S.c = bx;
              const bool lastu = (layer == DEPTH - 1 && half == 1);
              pg8::EpiResid E{P_XN, DM, 0.5f, P_RSS + (size_t)(cslot + 1) * M, lastu ? out : nullptr};
              pg8::gemm_phase<pg8::EpiResid, pg8::DualSched, true, true>(lds, FFN, S, E, ptid); }
            GRID_BAR();
            if (half == 0) {
                { PHASE_VARS
                  pg8::DualSched S; S.tstep = (size_t)256 * DM * 2; S.G = G; S.c = bx;
                  pg8::EpiBf16 E{P_PROJ, is_sb ? PROJ_SB : PROJ_S5, P_VT, M, 0x7fffffff};
                  if (is_sb) { const bf16* W = P_WINSB + (size_t)jj * 5120 * DM; S.t1.init(M, PROJ_SB); S.t2.init(TOKW, M);
                      S.A1 = (const char*)P_XN; S.B1 = (const char*)W; S.A2 = (const char*)(W + (size_t)PROJ_SB * DM); S.B2 = (const char*)P_XN; }
                  else { S.t1.init(M, PROJ_S5); S.t2.init(0, 0); S.A1 = (const char*)P_XN; S.B1 = (const char*)(P_WINS5 + (size_t)jj * DM * DM); S.A2 = S.A1; S.B2 = S.B1; }
                  pg8::gemm_phase<pg8::EpiBf16, pg8::DualSched, true, true>(lds, DM, S, E, ptid); }
                GRID_BAR();
                if (is_sb) {
                    { PHASE_VARS
                      const bf16* KNl = P_KN + (size_t)layer * 2 * 4 * NMEM * HD; const bf16* VTMl = P_VTM + (size_t)layer * 2 * 4 * HD * NMEM;
                      constexpr int NSB = BATCH * SBH * (SEQ / 32);
#pragma unroll 1
                      for (int u = gw; u < NSB; u += NGW) { const int qt = u % (SEQ / 32), bh = u / (SEQ / 32); sb_attn_wave(P_PROJ, P_VT, P_TOK, P_RSS + (size_t)(cslot + 1) * M, bh / SBH, bh % SBH, qt, lane, lds + wave * 8704); }
                      cross_attn_phase(P_PROJ, PROJ_SB, 2 * TOKW, KNl, VTMl, P_TOK, P_RSS + (size_t)(cslot + 1) * M, lds, vcu, G, ptid, wave, lane); }
                    GRID_BAR();
                } else {
                    constexpr int NS5 = BATCH * S5G * S5NC, NCR = BATCH * MEMHEADS * (SEQ / 32);
                    { PHASE_VARS
                      const bf16* KNl = P_KN + (size_t)layer * 2 * 4 * NMEM * HD; const bf16* VTMl = P_VTM + (size_t)layer * 2 * 4 * HD * NMEM;
                      const bf16* Bb = P_BBAR + (size_t)jj * S5G * 128 * 16; const bf16* Cc = P_CCAT + (size_t)jj * S5G * 16 * 128; const float* Ab = P_ABAR + (size_t)jj * S5G * 64 * 4;
                      const float* dsk = args.in[I_S5D] + (size_t)jj * TOKW;
                      LAS unsigned char* wl = lds + wave * S5_LDS_WAVE;
#pragma unroll 1
                      for (int u = gw; u < NS5; u += NGW) { const int c = u / (BATCH * S5G), bg = u % (BATCH * S5G); s5_pass0_wave(P_PROJ, Bb, Ab, P_EB, P_RSS + (size_t)(cslot + 1) * M, bg / S5G, bg % S5G, c, wl, lane); }
                      cross_attn_phase(P_PROJ, PROJ_S5, TOKW, KNl, VTMl, P_TOK, P_RSS + (size_t)(cslot + 1) * M, lds, vcu, G, ptid, wave, lane); }
                    GRID_BAR();
                    { PHASE_VARS
                      const bf16* Bb = P_BBAR + (size_t)jj * S5G * 128 * 16; const bf16* Cc = P_CCAT + (size_t)jj * S5G * 16 * 128; const float* Ab = P_ABAR + (size_t)jj * S5G * 64 * 4;
                      const float* dsk = args.in[I_S5D] + (size_t)jj * TOKW;
                      LAS unsigned char* wl = lds + wave * S5_LDS_WAVE;
#pragma unroll 1
                      for (int u = gw; u < NS5; u += NGW) { const int c = u / (BATCH * S5G), bg = u % (BATCH * S5G); s5_wave<1>(P_PROJ, Bb, Cc, Ab, dsk, P_EB, P_YB, P_RSS + (size_t)(cslot + 1) * M, bg / S5G, bg % S5G, c, wl, lane); } }
                    GRID_BAR();
                    { PHASE_VARS
                      pg8::DualSched S; S.t1.init(M, TOKW); S.t2.init(0, 0); S.A1 = (const char*)P_YB; S.B1 = (const char*)(P_WGLU + (size_t)jj * TOKW * TOKW); S.A2 = S.A1; S.B2 = S.B1;
                      S.tstep = (size_t)256 * TOKW * 2; S.G = G; S.c = bx;
                      pg8::EpiGLU E{P_YB, TOKW, P_TOK, DM};
                      pg8::gemm_phase<pg8::EpiGLU, pg8::DualSched, true, true>(lds, TOKW, S, E, ptid); }
                    GRID_BAR();
                }
                { PHASE_VARS
                  pg8::DualSched S; S.t1.init(M, DM); S.t2.init(0, 0); S.A1 = (const char*)P_TOK; S.B1 = (const char*)(P_WOUT + (size_t)layer * DM * DM); S.A2 = S.A1; S.B2 = S.B1;
                  S.tstep = (size_t)256 * DM * 2; S.G = G; S.c = bx;
                  pg8::EpiResid E{P_XN, DM, 1.0f, P_RSS + (size_t)(cslot + 2) * M, nullptr};
                  pg8::gemm_phase<pg8::EpiResid, pg8::DualSched, true, true>(lds, DM, S, E, ptid); }
                GRID_BAR();
            }
        }
    }
}

extern "C" void kernel_launch(void* const* d_in, const int* in_sizes, int n_in, void* d_out, int out_size, void* d_ws, size_t ws_size, hipStream_t stream) {
    static int grid = 0;
    if (grid == 0) {
        if (n_in != 25 || in_sizes[0] != M * DM || out_size != M * DM || ws_size < WS_END) {
            fprintf(stderr, "kernel_launch: shape/workspace mismatch: n_in %d in0 %d out %d ws %zu (need %zu)\n", n_in, n_in > 0 ? in_sizes[0] : -1, out_size, ws_size, (size_t)WS_END); grid = -1; return; }
        int dev = 0, cus = 0, per_cu = 0;
        if (hipGetDevice(&dev) != hipSuccess || hipDeviceGetAttribute(&cus, hipDeviceAttributeMultiprocessorCount, dev) != hipSuccess) { fprintf(stderr, "kernel_launch: device query failed\n"); grid = -1; return; }
        if (hipFuncSetAttribute((const void*)fwd, hipFuncAttributeMaxDynamicSharedMemorySize, LDS_BYTES) != hipSuccess) { fprintf(stderr, "kernel_launch: hipFuncSetAttribute failed\n"); grid = -1; return; }
        if (hipOccupancyMaxActiveBlocksPerMultiprocessor(&per_cu, (const void*)fwd, 512, LDS_BYTES) != hipSuccess || per_cu < 1)
            fprintf(stderr, "kernel_launch: note: occupancy query reports %d workgroups per CU\n", per_cu);
        (void)hipGetLastError();
        grid = cus;
    }
    if (grid < 0) return;
    if (hipMemsetAsync((char*)d_ws + WS_CTL, 0, CTL_ZERO_BYTES, stream) != hipSuccess) { fprintf(stderr, "kernel_launch: memset failed\n"); return; }
    Args a{};
    for (int i = 0; i < 25; ++i) a.in[i] = (const float*)d_in[i];
    a.out = (float*)d_out; a.ws = (unsigned char*)d_ws;
    hipLaunchKernelGGL(fwd, dim3(grid), dim3(512), LDS_BYTES, stream, a);
    const hipError_t le = hipPeekAtLastError();
    if (le != hipSuccess) fprintf(stderr, "kernel_launch: launch failed: %s\n", hipGetErrorName(le));
}
```
